# Optimizing an MI355X kernel written in HIP

```python
import math
import jax, jax.numpy as jnp
from jax import lax
import numpy as np

D_MODEL = 2048
BATCH = 8
SEQ = 2048
DEPTH = 2

N_A_LAYERS = DEPTH // 2
N_B_LAYERS = DEPTH - N_A_LAYERS
HEAD_DIM_A = 128
N_HEADS_A = D_MODEL // HEAD_DIM_A
DILATION_PATTERNS = ((128, 1), (512, 4), (2048, 16))
N_GROUPS_A = len(DILATION_PATTERNS)
DIFF_HEAD_DIM = 128
N_HEADS_B = D_MODEL // (2 * DIFF_HEAD_DIM)
DIFF_QK_WIDTH = N_HEADS_B * 2 * DIFF_HEAD_DIM
DIFF_V_WIDTH = N_HEADS_B * 2 * DIFF_HEAD_DIM
D_FF = ((8 * D_MODEL // 3 + 127) // 128) * 128
MACARON_WEIGHT = 0.5
Q_BLOCK = 128
RMS_EPS = 1e-6
SUBLN_EPS = 1e-5

kernel_name = 'yoco_dilated_diff_macaron'


def rms_norm(x, gain, eps=RMS_EPS):
    xf = x.astype(jnp.float32)
    y = xf * lax.rsqrt(jnp.mean(xf * xf, axis=-1, keepdims=True) + eps)
    return (y * gain.astype(jnp.float32)).astype(x.dtype)


def swiglu(h, w_in, w_out):
    gate, up = jnp.split(h @ w_in, 2, axis=-1)
    return (jax.nn.silu(gate) * up) @ w_out


def alibi_slopes(n_heads):
    return 2.0 ** (-8.0 * jnp.arange(1, n_heads + 1, dtype=jnp.float32) / n_heads)


def diff_lambda_init(layer_idx):
    return 0.8 - 0.6 * math.exp(-0.3 * layer_idx)


def dilated_window_branch(q, k, v, slopes, window, dilation):
    b, s, h, dh = q.shape
    n_back = window // dilation
    sub_len = s // dilation
    n_blk = -(-sub_len // n_back)
    pad = n_blk * n_back - sub_len

    def strided(t):
        t = t.reshape(b, sub_len, dilation, h, dh).transpose(0, 2, 3, 1, 4)
        t = jnp.pad(t, ((0, 0), (0, 0), (0, 0), (0, pad), (0, 0)))
        return t.reshape(b, dilation, h, n_blk, n_back, dh)

    def with_prev_block(t):
        prev = jnp.pad(t, ((0, 0), (0, 0), (0, 0), (1, 0), (0, 0), (0, 0)))[:, :, :, :-1]
        return jnp.concatenate([prev, t], axis=4)

    qb = strided(q)
    kb = with_prev_block(strided(k))
    vb = with_prev_block(strided(v))
    scores = jnp.einsum('bchnqe,bchnke->bchnqk', qb, kb,
                        preferred_element_type=jnp.float32) * (dh ** -0.5)
    steps = jnp.arange(n_back)[:, None] + n_back - jnp.arange(2 * n_back)[None, :]
    key_idx = (jnp.arange(n_blk)[:, None, None] - 1) * n_back + jnp.arange(2 * n_back)[None, None, :]
    valid = (steps >= 0) & (steps <= n_back) & (key_idx >= 0)
    bias = -slopes[:, None, None, None] * (dilation * steps).astype(jnp.float32)
    scores = jnp.where(valid, scores + bias, -jnp.inf)
    lse = jax.nn.logsumexp(scores, axis=-1)
    probs = jnp.exp(scores - lse[..., None])
    out = jnp.einsum('bchnqk,bchnke->bchnqe', probs.astype(v.dtype), vb)
    out = out.reshape(b, dilation, h, n_blk * n_back, dh)[:, :, :, :sub_len]
    out = out.transpose(0, 3, 1, 2, 4).reshape(b, s, h, dh)
    lse = lse.reshape(b, dilation, h, n_blk * n_back)[..., :sub_len]
    lse = lse.transpose(0, 3, 1, 2).reshape(b, s, h)
    return out, lse


def dilated_attention_mixer(hn, w_qkv, w_o, slopes):
    b, s, _ = hn.shape
    qkv = (hn @ w_qkv).reshape(b, s, 3, N_GROUPS_A, N_HEADS_A, HEAD_DIM_A)
    outs, lses = [], []
    for g, (window, dilation) in enumerate(DILATION_PATTERNS):
        o, l = dilated_window_branch(qkv[:, :, 0, g], qkv[:, :, 1, g], qkv[:, :, 2, g],
                                     slopes, window, dilation)
        outs.append(o)
        lses.append(l)
    weights = jax.nn.softmax(jnp.stack(lses, axis=0), axis=0)
    merged = jnp.einsum('gbsh,gbshe->bshe', weights, jnp.stack(outs, axis=0).astype(jnp.float32))
    return merged.reshape(b, s, N_HEADS_A * HEAD_DIM_A).astype(hn.dtype) @ w_o


def shared_kv(x, gain, w_kv):
    b, s, _ = x.shape
    kv = rms_norm(x, gain) @ w_kv
    k = kv[..., :DIFF_QK_WIDTH].reshape(b, s, N_HEADS_B, 2, DIFF_HEAD_DIM)
    v = kv[..., DIFF_QK_WIDTH:].reshape(b, s, N_HEADS_B, 2 * DIFF_HEAD_DIM)
    return k, v


def differential_attention_mixer(hn, k, v, w_q, lam, subln_gain, w_o, slopes, lambda_init):
    b, s, _ = hn.shape
    q = (hn @ w_q).reshape(b, s, N_HEADS_B, 2, DIFF_HEAD_DIM)
    lam_f = lam.astype(jnp.float32)
    lam_full = (jnp.exp(jnp.sum(lam_f[0] * lam_f[1])) - jnp.exp(jnp.sum(lam_f[2] * lam_f[3]))
                + lambda_init)
    scale = DIFF_HEAD_DIM ** -0.5
    outs = []
    for start in range(0, s, Q_BLOCK):
        end = start + Q_BLOCK
        sc = jnp.einsum('bqhmd,bkhmd->bhmqk', q[:, start:end], k[:, :end],
                        preferred_element_type=jnp.float32) * scale
        qpos = jnp.arange(start, end)[:, None]
        kpos = jnp.arange(end)[None, :]
        dist = (qpos - kpos).astype(jnp.float32)
        sc = jnp.where(qpos >= kpos, sc - slopes[:, None, None, None] * dist, -jnp.inf)
        p = jax.nn.softmax(sc, axis=-1)
        attn = p[:, :, 0] - lam_full * p[:, :, 1]
        outs.append(jnp.einsum('bhqk,bkhe->bqhe', attn.astype(v.dtype), v[:, :end]))
    o = jnp.concatenate(outs, axis=1)
    o = rms_norm(o, subln_gain, SUBLN_EPS) * (1.0 - lambda_init)
    return o.reshape(b, s, DIFF_V_WIDTH) @ w_o


def setup_inputs(seed: int = 0) -> dict:
    key = jax.random.key(seed)
    ks = jax.random.split(key, 13)
    f32 = jnp.float32

    def dense(k, shape, fan_in):
        return jax.random.normal(k, shape, f32) * fan_in ** -0.5

    def gain(k, shape):
        return 1.0 + 0.02 * jax.random.normal(k, shape, f32)

    qkv_a_width = 3 * N_GROUPS_A * N_HEADS_A * HEAD_DIM_A
    return {
        'x': jax.random.normal(ks[0], (BATCH, SEQ, D_MODEL), f32),
        'norm_gains': gain(ks[1], (DEPTH, 3, D_MODEL)),
        'ffn_w_in': dense(ks[2], (DEPTH, 2, D_MODEL, 2 * D_FF), D_MODEL),
        'ffn_w_out': dense(ks[3], (DEPTH, 2, D_FF, D_MODEL), D_FF),
        'a_w_qkv': dense(ks[4], (N_A_LAYERS, D_MODEL, qkv_a_width), D_MODEL),
        'a_w_o': dense(ks[5], (N_A_LAYERS, N_HEADS_A * HEAD_DIM_A, D_MODEL), N_HEADS_A * HEAD_DIM_A),
        'kv_norm_gain': gain(ks[6], (D_MODEL,)),
        'b_w_kv': dense(ks[7], (D_MODEL, DIFF_QK_WIDTH + DIFF_V_WIDTH), D_MODEL),
        'b_w_q': dense(ks[8], (N_B_LAYERS, D_MODEL, DIFF_QK_WIDTH), D_MODEL),
        'b_lambda': 0.1 * jax.random.normal(ks[9], (N_B_LAYERS, 4, DIFF_HEAD_DIM), f32),
        'b_subln_gain': gain(ks[10], (N_B_LAYERS, 2 * DIFF_HEAD_DIM)),
        'b_w_o': dense(ks[11], (N_B_LAYERS, DIFF_V_WIDTH, D_MODEL), DIFF_V_WIDTH),
        'final_norm_gain': gain(ks[12], (D_MODEL,)),
    }


def reference(x, norm_gains, ffn_w_in, ffn_w_out, a_w_qkv, a_w_o, kv_norm_gain, b_w_kv,
              b_w_q, b_lambda, b_subln_gain, b_w_o, final_norm_gain):
    slopes_a = alibi_slopes(N_HEADS_A)
    slopes_b = alibi_slopes(N_HEADS_B)
    k_shared, v_shared = None, None
    for layer in range(DEPTH):
        x = x + MACARON_WEIGHT * swiglu(rms_norm(x, norm_gains[layer, 0]),
                                        ffn_w_in[layer, 0], ffn_w_out[layer, 0])
        hn = rms_norm(x, norm_gains[layer, 1])
        if layer < N_A_LAYERS:
            x = x + dilated_attention_mixer(hn, a_w_qkv[layer], a_w_o[layer], slopes_a)
        else:
            j = layer - N_A_LAYERS
            x = x + differential_attention_mixer(hn, k_shared, v_shared, b_w_q[j], b_lambda[j],
                                                 b_subln_gain[j], b_w_o[j], slopes_b,
                                                 diff_lambda_init(layer))
        x = x + MACARON_WEIGHT * swiglu(rms_norm(x, norm_gains[layer, 2]),
                                        ffn_w_in[layer, 1], ffn_w_out[layer, 1])
        if layer == N_A_LAYERS - 1:
            k_shared, v_shared = shared_kv(x, kv_norm_gain, b_w_kv)
    return rms_norm(x, final_norm_gain)
```

```cpp
#include <hip/hip_runtime.h>
#include <hip/hip_cooperative_groups.h>
#include <cstdio>
#include <cstdint>
namespace cg = cooperative_groups;

#ifndef ONE_LAUNCH
#define ONE_LAUNCH 1
#endif
#ifndef REP_OP
#define REP_OP -1
#define REP_N 1
#endif
#ifndef SYNC_EXTRA
#define SYNC_EXTRA 0
#endif

#define LAS __attribute__((address_space(3)))
typedef unsigned short bf16_t;
typedef short bf16x8 __attribute__((ext_vector_type(8)));
typedef float f32x4 __attribute__((ext_vector_type(4)));
typedef float f32x16 __attribute__((ext_vector_type(16)));
typedef unsigned u32x4 __attribute__((ext_vector_type(4)));
typedef unsigned u32x2 __attribute__((ext_vector_type(2)));
typedef float f32x2_t __attribute__((ext_vector_type(2)));
typedef __bf16 bf16x2_t __attribute__((ext_vector_type(2)));

constexpr int MTOK = 16384, DM = 2048, FF = 5504, SEQ = 2048;
constexpr int NWAVES = 8, NTHREADS = 512;
constexpr int LDS_BYTES = 147456;
constexpr float LOG2E = 1.4426950408889634f;

__device__ __forceinline__ unsigned pk2(float lo, float hi) { f32x2_t v = {lo, hi}; bf16x2_t b = __builtin_convertvector(v, bf16x2_t); return __builtin_bit_cast(unsigned, b); }
__device__ __forceinline__ float bflo(unsigned u) { return __uint_as_float(u << 16); }
__device__ __forceinline__ float bfhi(unsigned u) { return __uint_as_float(u & 0xffff0000u); }
__device__ __forceinline__ float wave_sum(float v) {
#pragma unroll
    for (int o = 1; o < 64; o <<= 1) v += __shfl_xor(v, o);
    return v;
}
#define LDS_WAIT() asm volatile("s_waitcnt lgkmcnt(0)" ::: "memory")

namespace pg8 {
constexpr int MTOK_ = 16384; constexpr int BM = 256, BK = 64, HALF = 128, HTB = HALF * BK * 2, STAGE_BYTES = 8 * HTB, NXCD = 8, WGM = 8;
__host__ __device__ __forceinline__ int lds_byte(int r, int c) { const int st = (r >> 4) * 2 + (c >> 5), rr = r & 15, cc = c & 31, ob = rr * 64 + cc * 2; return st * 1024 + (ob ^ (((ob >> 9) & 1) << 5)); }
__host__ __device__ __forceinline__ void stage_rc(int b, int& R, int& C) { const int st = b / 1024, sb = b % 1024, swz = sb ^ (((sb >> 9) & 1) << 5); R = (st >> 1) * 16 + swz / 64; C = (st & 1) * 32 + (swz % 64) / 2; }
__host__ __device__ __forceinline__ int perm32(int rho) { const int n = rho >> 4, i = rho & 15; return 8 * (i >> 2) + 4 * n + (i & 3); }

struct Unit { int pm, pn; };
struct Gemm { const bf16_t* A; const bf16_t* Bt; int M, N, K; };

struct StaticOrder {
    int nM, nN, nwg, G, c, wgm;
    __device__ void init(int M, int N, int G_, int c_, int wgm_ = WGM) { nM = M / BM; nN = N / BM; nwg = nM * nN; G = G_; c = c_; wgm = wgm_; }
    __device__ bool next(int i, Unit& u) const {
        const long L = (long)i * G + c; if (L >= nwg) return false;
        int wgid = (int)L; { const int q = nwg / NXCD, r = nwg % NXCD, xcd = wgid % NXCD, off = wgid / NXCD; wgid = (xcd < r ? xcd * (q + 1) : r * (q + 1) + (xcd - r) * q) + off; }
        const int nig = wgm * nN, gid = wgid / nig, fm = gid * wgm, gsz = (nM - fm) < wgm ? (nM - fm) : wgm;
        u.pm = fm + ((wgid % nig) % gsz); u.pn = (wgid % nig) / gsz; return true;
    }
};

__device__ __forceinline__ int inv_perm(int idx, int pm) {
    const int pr = idx & 2047, bb = idx & ~2047;
    return pm == 0 ? idx : (pm == 1 ? bb + (pr & 511) * 4 + (pr >> 9) : bb + (pr & 127) * 16 + (pr >> 7));
}
__device__ __forceinline__ float rstd_row(const float* ss, int tok, int fq) {
    const f32x4 a = *(const f32x4*)(ss + (size_t)tok * 32 + fq * 8), b = *(const f32x4*)(ss + (size_t)tok * 32 + fq * 8 + 4);
    float p = ((a[0] + a[1]) + (a[2] + a[3])) + ((b[0] + b[1]) + (b[2] + b[3]));
    p += __shfl_xor(p, 16); p += __shfl_xor(p, 32);
    return rsqrtf(p * (1.f / 2048.f) + 1e-6f);
}
__device__ __forceinline__ float rstd_full(const float* ss, int tok) {
    float p = 0.f;
#pragma unroll
    for (int k = 0; k < 8; ++k) { const f32x4 a = *(const f32x4*)(ss + (size_t)tok * 32 + 4 * k); p += (a[0] + a[1]) + (a[2] + a[3]); }
    return rsqrtf(p * (1.f / 2048.f) + 1e-6f);
}
struct EpiBf16 {
    static constexpr bool PERM = true;
    bf16_t* O; int ldc; const float* ss; int mode;
    __device__ __forceinline__ void operator()(const f32x4 (&acc)[2][2][4][2], const Unit& u, int wr, int wc, int fr, int fq) const {
        const int row0 = u.pm * BM + wr * 64 + fr, col0 = u.pn * BM + wc * 32 + 8 * fq;
        if (mode < 3) {
#pragma unroll
            for (int ai = 0; ai < 2; ++ai)
#pragma unroll
                for (int m = 0; m < 4; ++m) { const int row = row0 + ai * HALF + m * 16; const float rs = rstd_row(ss, inv_perm(row, mode), fq);
                    bf16_t* rowp = O + (size_t)row * ldc + col0;
#pragma unroll
                    for (int bj = 0; bj < 2; ++bj) { const f32x4 v0 = acc[ai][bj][m][0] * rs, v1 = acc[ai][bj][m][1] * rs;
                        u32x4 w; w.x = pk2(v0[0], v0[1]); w.y = pk2(v0[2], v0[3]); w.z = pk2(v1[0], v1[1]); w.w = pk2(v1[2], v1[3]);
                        *(u32x4*)(rowp + bj * HALF) = w; } }
        } else {
            f32x4 cs[2][2];
            const float mine = rstd_full(ss, inv_perm(col0 + (fr >> 3) * HALF + (fr & 7), mode - 3));
#pragma unroll
            for (int bj = 0; bj < 2; ++bj)
#pragma unroll
                for (int n = 0; n < 2; ++n)
#pragma unroll
                    for (int j = 0; j < 4; ++j) cs[bj][n][j] = __shfl(mine, fq * 16 + bj * 8 + n * 4 + j);
#pragma unroll
            for (int ai = 0; ai < 2; ++ai)
#pragma unroll
                for (int m = 0; m < 4; ++m) { const int row = row0 + ai * HALF + m * 16;
#pragma unroll
                    for (int bj = 0; bj < 2; ++bj) { const f32x4 v0 = acc[ai][bj][m][0] * cs[bj][0], v1 = acc[ai][bj][m][1] * cs[bj][1];
                        u32x4 w; w.x = pk2(v0[0], v0[1]); w.y = pk2(v0[2], v0[3]); w.z = pk2(v1[0], v1[1]); w.w = pk2(v1[2], v1[3]);
                        const int c = col0 + bj * HALF;
                        *(u32x4*)(O + ((size_t)(c >> 6) * 2048 + row) * 64 + (c & 63)) = w; } }
        }
    }
};
__device__ __forceinline__ float swiglu1(float g, float up) { return g * __builtin_amdgcn_rcpf(1.0f + __expf(-g)) * up; }
struct EpiSwiGLU {
    static constexpr bool PERM = true;
    bf16_t* O; int ldc; const float* ss;
    __device__ __forceinline__ void operator()(const f32x4 (&acc)[2][2][4][2], const Unit& u, int wr, int wc, int fr, int fq) const {
        const int row0 = u.pm * BM + wr * 64 + fr, col0 = u.pn * HALF + wc * 32 + 8 * fq;
#pragma unroll
        for (int ai = 0; ai < 2; ++ai)
#pragma unroll
            for (int m = 0; m < 4; ++m) { const int row = row0 + ai * HALF + m * 16; const float rs = rstd_row(ss, row, fq);
                bf16_t* rowp = O + (size_t)row * ldc + col0;
                const f32x4 g0 = acc[ai][0][m][0] * rs, g1 = acc[ai][0][m][1] * rs, u0 = acc[ai][1][m][0] * rs, u1 = acc[ai][1][m][1] * rs;
                u32x4 w;
                w.x = pk2(swiglu1(g0[0], u0[0]), swiglu1(g0[1], u0[1])); w.y = pk2(swiglu1(g0[2], u0[2]), swiglu1(g0[3], u0[3]));
                w.z = pk2(swiglu1(g1[0], u1[0]), swiglu1(g1[1], u1[1])); w.w = pk2(swiglu1(g1[2], u1[2]), swiglu1(g1[3], u1[3]));
                *(u32x4*)rowp = w; }
    }
};
struct EpiResid {
    static constexpr bool PERM = true;
    float* out; int ldc; float scale; bf16_t* xb; float* ss; int perm; int f32out; const bf16_t* xin;
    __device__ __forceinline__ void operator()(const f32x4 (&acc)[2][2][4][2], const Unit& u, int wr, int wc, int fr, int fq) const {
        const int row0 = u.pm * BM + wr * 64 + fr, col0 = u.pn * BM + wc * 32 + 8 * fq;
#pragma unroll
        for (int ai = 0; ai < 2; ++ai) {
            u32x4 bs[4][2];
#pragma unroll
            for (int m = 0; m < 4; ++m)
#pragma unroll
                for (int bj = 0; bj < 2; ++bj) bs[m][bj] = *(const u32x4*)(xin + (size_t)(row0 + ai * HALF + m * 16) * ldc + col0 + bj * HALF);
#pragma unroll
            for (int m = 0; m < 4; ++m) { const int row = row0 + ai * HALF + m * 16; const size_t off = (size_t)row * ldc + col0;
                const int bb = row & ~2047, t = row & 2047;
                const size_t o4 = (size_t)(bb + (t & 3) * 512 + (t >> 2)) * ldc + col0, o16 = (size_t)(bb + (t & 15) * 128 + (t >> 4)) * ldc + col0;
                float sq = 0.f;
#pragma unroll
                for (int bj = 0; bj < 2; ++bj) { const u32x4 b = bs[m][bj];
                    const f32x4 v0 = (f32x4){bflo(b.x), bfhi(b.x), bflo(b.y), bfhi(b.y)} + acc[ai][bj][m][0] * scale;
                    const f32x4 v1 = (f32x4){bflo(b.z), bfhi(b.z), bflo(b.w), bfhi(b.w)} + acc[ai][bj][m][1] * scale;
                    sq += ((v0[0] * v0[0] + v0[1] * v0[1]) + (v0[2] * v0[2] + v0[3] * v0[3])) + ((v1[0] * v1[0] + v1[1] * v1[1]) + (v1[2] * v1[2] + v1[3] * v1[3]));
                    u32x4 w; w.x = pk2(v0[0], v0[1]); w.y = pk2(v0[2], v0[3]); w.z = pk2(v1[0], v1[1]); w.w = pk2(v1[2], v1[3]);
                    *(u32x4*)(xb + off + bj * HALF) = w;
                    if (perm) { *(u32x4*)(xb + (size_t)MTOK_ * ldc + o4 + bj * HALF) = w; *(u32x4*)(xb + (size_t)2 * MTOK_ * ldc + o16 + bj * HALF) = w; }
                    if (f32out) { *(f32x4*)(out + off + bj * HALF) = v0; *(f32x4*)(out + off + bj * HALF + 4) = v1; } }
                sq += __shfl_xor(sq, 16); sq += __shfl_xor(sq, 32);
                if (fq == 0) ss[(size_t)row * 32 + u.pn * 4 + wc] = sq; }
            asm volatile("" ::: "memory");
        }
    }
};

template <int K, class Epi, class Sched, bool ALIGN_EPI, bool SP2>
__device__ __forceinline__ void gemm_phase(LAS unsigned char* lds, const Gemm g, const Sched& S, const Epi& E, const int tid) {
    const int wid = __builtin_amdgcn_readfirstlane(tid >> 6), lane = tid & 63, wr = wid >> 2, wc = wid & 3, fr = lane & 15, fq = lane >> 4;
    constexpr int nt = K / BK;
    unsigned voffA[2], voffB[2];
#pragma unroll
    for (int i = 0; i < 2; ++i) { int R, C; stage_rc(tid * 16 + i * 8192, R, C); const int Rb = Epi::PERM ? ((R & ~31) + perm32(R & 31)) : R;
        voffA[i] = (unsigned)(R * K + C) * 2u; voffB[i] = (unsigned)(Rb * K + C) * 2u; }
    const size_t kstep = (size_t)(BK * 2);
    const size_t hstep = (size_t)HALF * K * 2;
    const size_t tstep = 2 * hstep;
    const unsigned ldsw = (unsigned)wid * 1024u;
    const int aoff = lds_byte(wr * 64 + fr, fq * 8), boff = lds_byte(wc * 32 + fr, fq * 8);
#define PG8_SA(b, h) (((b) * 2 + (h)) * HTB)
#define PG8_SB(b, h) ((4 + (b) * 2 + (h)) * HTB)
#define PG8_STAGE(bufoff, gbase, voff) do { _Pragma("unroll") for (int _i = 0; _i < 2; ++_i) \
        __builtin_amdgcn_global_load_lds((const unsigned*)((const char*)(gbase) + (voff)[_i]), (LAS unsigned*)(lds + (bufoff) + ldsw + _i * 8192), 16, 0, 0); } while (0)
#define PG8_LDA(dst, b, h) do { _Pragma("unroll") for (int m = 0; m < 4; ++m) _Pragma("unroll") for (int k = 0; k < 2; ++k) dst[m][k] = *(const LAS bf16x8*)(lds + PG8_SA(b, h) + aoff + m * 2048 + k * 1024); } while (0)
#define PG8_LDB(dst, b, h) do { _Pragma("unroll") for (int n = 0; n < 2; ++n) _Pragma("unroll") for (int k = 0; k < 2; ++k) dst[n][k] = *(const LAS bf16x8*)(lds + PG8_SB(b, h) + boff + n * 2048 + k * 1024); } while (0)
#define PG8_MMA(ai, bj, At, Bt) do { __builtin_amdgcn_s_setprio(1); _Pragma("unroll") for (int m = 0; m < 4; ++m) _Pragma("unroll") for (int n = 0; n < 2; ++n) _Pragma("unroll") for (int k = 0; k < 2; ++k) \
        acc[ai][bj][m][n] = __builtin_amdgcn_mfma_f32_16x16x32_bf16(Bt[n][k], At[m][k], acc[ai][bj][m][n], 0, 0, 0); __builtin_amdgcn_s_setprio(0); } while (0)
#define PG8_WAIT_V(n) asm volatile("s_waitcnt vmcnt(" #n ")" ::: "memory")
#define PG8_WAIT_L(n) asm volatile("s_waitcnt lgkmcnt(" #n ")" ::: "memory")
#define PG8_BAR __builtin_amdgcn_s_barrier()
#define PG8_SCHED __builtin_amdgcn_sched_barrier(0)
    Unit cur, nxt; int ui = 0;
    if (!S.next(0, cur)) return;
    f32x4 acc[2][2][4][2];
#pragma unroll
    for (int a = 0; a < 2; ++a)
#pragma unroll
        for (int b = 0; b < 2; ++b)
#pragma unroll
            for (int m = 0; m < 4; ++m)
#pragma unroll
                for (int n = 0; n < 2; ++n) acc[a][b][m][n] = (f32x4){0.f, 0.f, 0.f, 0.f};
    bf16x8 At[4][2], B0[2][2], B1[2][2];
    const char* cA = (const char*)g.A + (size_t)cur.pm * tstep; const char* cB = (const char*)g.Bt + (size_t)cur.pn * tstep;
    if constexpr (SP2) {
        PG8_STAGE(PG8_SB(0, 0), cB, voffB); PG8_STAGE(PG8_SB(0, 1), cB + hstep, voffB); PG8_STAGE(PG8_SA(0, 0), cA, voffA); PG8_STAGE(PG8_SA(0, 1), cA + hstep, voffA);
        if (wr == 1) PG8_BAR;
        PG8_WAIT_V(2); PG8_BAR;
        PG8_STAGE(PG8_SB(1, 0), cB + kstep, voffB); PG8_STAGE(PG8_SA(1, 0), cA + kstep, voffA); PG8_STAGE(PG8_SB(1, 1), cB + hstep + kstep, voffB);
        PG8_WAIT_V(6); PG8_BAR;
    } else {
        PG8_STAGE(PG8_SB(0, 0), cB, voffB); PG8_STAGE(PG8_SA(0, 0), cA, voffA); PG8_STAGE(PG8_SB(0, 1), cB + hstep, voffB); PG8_STAGE(PG8_SA(0, 1), cA + hstep, voffA);
        if (wr == 1) PG8_BAR;
        PG8_WAIT_V(4); PG8_BAR;
        PG8_STAGE(PG8_SB(1, 0), cB + kstep, voffB); PG8_STAGE(PG8_SA(1, 0), cA + kstep, voffA); PG8_STAGE(PG8_SB(1, 1), cB + hstep + kstep, voffB);
        PG8_WAIT_V(6); PG8_BAR;
    }
    for (;;) {
        const bool has_next = S.next(ui + 1, nxt);
        const char* nA = has_next ? (const char*)g.A + (size_t)nxt.pm * tstep : cA; const char* nB = has_next ? (const char*)g.Bt + (size_t)nxt.pn * tstep : cB;
        for (int t = 0; t < nt; t += 2) {
            const bool last = (t == nt - 2);
            const char* a1 = cA + (size_t)(t + 1) * kstep;
            const char* a2 = last ? nA : cA + (size_t)(t + 2) * kstep; const char* b2 = last ? nB : cB + (size_t)(t + 2) * kstep;
            const char* a3 = a2 + kstep; const char* b3 = b2 + kstep;
            if constexpr (SP2) {
            PG8_LDB(B0, 0, 0); PG8_LDB(B1, 0, 1); PG8_SCHED; PG8_LDA(At, 0, 0); PG8_STAGE(PG8_SA(1, 1), a1 + hstep, voffA);
            PG8_WAIT_V(8); PG8_WAIT_L(0); PG8_BAR; PG8_MMA(0, 0, At, B0); PG8_MMA(0, 1, At, B1); PG8_BAR; PG8_SCHED;
            PG8_LDA(At, 0, 1); PG8_STAGE(PG8_SB(0, 0), b2, voffB); PG8_STAGE(PG8_SB(0, 1), b2 + hstep, voffB); PG8_STAGE(PG8_SA(0, 0), a2, voffA);
            PG8_WAIT_V(8); PG8_WAIT_L(0); PG8_BAR; PG8_MMA(1, 0, At, B0); PG8_MMA(1, 1, At, B1); PG8_BAR; PG8_SCHED;
            PG8_LDB(B0, 1, 0); PG8_LDB(B1, 1, 1); PG8_SCHED; PG8_LDA(At, 1, 0); PG8_STAGE(PG8_SA(0, 1), a2 + hstep, voffA);
            PG8_WAIT_V(8); PG8_WAIT_L(0); PG8_BAR; PG8_MMA(0, 0, At, B0); PG8_MMA(0, 1, At, B1); PG8_BAR; PG8_SCHED;
            PG8_LDA(At, 1, 1); PG8_STAGE(PG8_SB(1, 0), b3, voffB); PG8_STAGE(PG8_SB(1, 1), b3 + hstep, voffB); PG8_STAGE(PG8_SA(1, 0), a3, voffA);
            PG8_WAIT_V(8); PG8_WAIT_L(0); PG8_BAR; PG8_MMA(1, 0, At, B0); PG8_MMA(1, 1, At, B1); PG8_BAR; PG8_SCHED;
            } else {
            PG8_LDB(B0, 0, 0); PG8_SCHED; PG8_LDA(At, 0, 0); PG8_STAGE(PG8_SA(1, 1), a1 + hstep, voffA);
            PG8_WAIT_L(8); PG8_BAR; PG8_WAIT_L(0); PG8_MMA(0, 0, At, B0); PG8_BAR; PG8_SCHED;
            PG8_LDB(B1, 0, 1); PG8_STAGE(PG8_SB(0, 0), b2, voffB);
            PG8_BAR; PG8_WAIT_L(0); PG8_MMA(0, 1, At, B1); PG8_BAR;
            PG8_LDA(At, 0, 1); PG8_STAGE(PG8_SA(0, 0), a2, voffA);
            PG8_BAR; PG8_WAIT_L(0); PG8_MMA(1, 0, At, B0); PG8_BAR; PG8_SCHED;
            PG8_STAGE(PG8_SB(0, 1), b2 + hstep, voffB);
            PG8_WAIT_V(6); PG8_BAR; PG8_MMA(1, 1, At, B1); PG8_BAR;
            PG8_LDB(B0, 1, 0); PG8_SCHED; PG8_LDA(At, 1, 0); PG8_STAGE(PG8_SA(0, 1), a2 + hstep, voffA);
            PG8_WAIT_L(8); PG8_BAR; PG8_WAIT_L(0); PG8_MMA(0, 0, At, B0); PG8_BAR; PG8_SCHED;
            PG8_LDB(B1, 1, 1); PG8_STAGE(PG8_SB(1, 0), b3, voffB);
            PG8_BAR; PG8_WAIT_L(0); PG8_MMA(0, 1, At, B1); PG8_BAR;
            PG8_LDA(At, 1, 1); PG8_STAGE(PG8_SA(1, 0), a3, voffA);
            PG8_BAR; PG8_WAIT_L(0); PG8_MMA(1, 0, At, B0); PG8_BAR; PG8_SCHED;
            PG8_STAGE(PG8_SB(1, 1), b3 + hstep, voffB);
            PG8_WAIT_V(6); PG8_BAR; PG8_MMA(1, 1, At, B1); PG8_BAR;
            }
        }
        if constexpr (ALIGN_EPI) { if (wr == 0) PG8_BAR; }
        E(acc, cur, wr, wc, fr, fq);
        if (!has_next) break;
#pragma unroll
        for (int a = 0; a < 2; ++a)
#pragma unroll
            for (int b = 0; b < 2; ++b)
#pragma unroll
                for (int m = 0; m < 4; ++m)
#pragma unroll
                    for (int n = 0; n < 2; ++n) acc[a][b][m][n] = (f32x4){0.f, 0.f, 0.f, 0.f};
        cur = nxt; cA = nA; cB = nB; ++ui;
        if constexpr (ALIGN_EPI) { if (wr == 1) PG8_BAR; }
    }
    PG8_WAIT_V(0);
    if constexpr (!ALIGN_EPI) { if (wr == 0) PG8_BAR; }
    PG8_BAR;
#undef PG8_SA
#undef PG8_SB
#undef PG8_STAGE
#undef PG8_LDA
#undef PG8_LDB
#undef PG8_MMA
#undef PG8_WAIT_V
#undef PG8_WAIT_L
#undef PG8_BAR
#undef PG8_SCHED
}
}

constexpr size_t MiB = 1u << 20;
constexpr size_t SZ_WIN = (size_t)2 * FF * DM * 2;
constexpr size_t SZ_WOUT = (size_t)DM * FF * 2;
constexpr size_t WS_WIN = 1 * MiB;
constexpr size_t WS_WOUT = WS_WIN + 4 * SZ_WIN;
constexpr size_t WS_WA = WS_WOUT + 4 * SZ_WOUT;
constexpr size_t WS_WOA = WS_WA + (size_t)18432 * DM * 2;
constexpr size_t WS_WKV = WS_WOA + (size_t)DM * DM * 2;
constexpr size_t WS_WQ = WS_WKV + (size_t)4096 * DM * 2;
constexpr size_t WS_WOB = WS_WQ + (size_t)DM * DM * 2;
constexpr size_t WS_XN = WS_WOB + (size_t)DM * DM * 2;
constexpr size_t SZ_XN = (size_t)MTOK * DM * 2;
constexpr size_t WS_BIG = WS_XN + 3 * SZ_XN;
constexpr size_t SZ_QK = (size_t)MTOK * 4096 * 2;
constexpr size_t WS_VT = WS_BIG + 3 * SZ_QK;
constexpr size_t WS_AO = WS_VT + 3 * SZ_XN;
constexpr size_t WS_LSE = WS_AO + SZ_XN;
constexpr size_t WS_OG0 = WS_LSE + 3 * MiB;
constexpr size_t WS_SSP = WS_OG0 + SZ_XN;
constexpr size_t WS_END = WS_SSP + 7 * 2 * MiB;
constexpr size_t WS_O1 = WS_BIG + 192 * MiB;

__device__ __forceinline__ void tr_item64(const float* __restrict__ W, int ldw, int K, bf16_t* WT, int src_col0, int dst_row0, int k0, LAS float* scr, int lane, const float* gain) {
    const int cq = lane & 15, rr = lane >> 4;
    f32x4 v[16];
#pragma unroll
    for (int i = 0; i < 16; ++i) v[i] = *(const f32x4*)(W + (size_t)(k0 + 4 * i + rr) * ldw + src_col0 + 4 * cq);
#pragma unroll
    for (int i = 0; i < 16; ++i) { LAS float* s = scr + (4 * i + rr) * 65 + 4 * cq; const float gk = gain ? gain[k0 + 4 * i + rr] : 1.f; s[0] = v[i].x * gk; s[1] = v[i].y * gk; s[2] = v[i].z * gk; s[3] = v[i].w * gk; }
    LDS_WAIT(); asm volatile("" ::: "memory");
    const int c = lane & 7;
#pragma unroll
    for (int j = 0; j < 8; ++j) { const int n = (lane >> 3) + 8 * j; const LAS float* s = scr + (8 * c) * 65 + n;
        u32x4 o; o.x = pk2(s[0 * 65], s[1 * 65]); o.y = pk2(s[2 * 65], s[3 * 65]); o.z = pk2(s[4 * 65], s[5 * 65]); o.w = pk2(s[6 * 65], s[7 * 65]);
        *(u32x4*)(WT + (size_t)(dst_row0 + n) * K + k0 + 8 * c) = o; }
    LDS_WAIT(); asm volatile("" ::: "memory");
}
__device__ __forceinline__ void conv_matrix(const float* W, int K, int N, bf16_t* WT, int kind, LAS float* scr, int gw, int NGW, int lane, const float* gain) {
    const int nnb = N / 64, items = (K / 64) * nnb;
    for (int it = gw; it < items; it += NGW) {
        const int kb = it / nnb, nb = it - kb * nnb, n0 = nb * 64;
        int d0 = n0;
        if (kind == 1) { const int half = n0 >= FF ? 1 : 0, j = n0 - half * FF; d0 = (j >> 7) * 256 + half * 128 + (j & 127); }
        else if (kind == 2) { const int sg = n0 >> 11, s = sg / 3, g = sg - 3 * s; d0 = g * 6144 + s * 2048 + (n0 & 2047); }
        tr_item64(W, N, K, WT, n0, d0, kb * 64, scr, lane, gain);
    }
}

__device__ __forceinline__ void prep_op(const float* in, bf16_t* xb, float* ss, int gw, int NGW, int lane) {
    for (int row = gw; row < MTOK; row += NGW) {
        const f32x4* xr = (const f32x4*)(in + (size_t)row * DM) + lane;
        f32x4 v[8]; float s = 0.f;
#pragma unroll
        for (int j = 0; j < 8; ++j) { v[j] = xr[64 * j]; s += (v[j].x * v[j].x + v[j].y * v[j].y) + (v[j].z * v[j].z + v[j].w * v[j].w); }
        s = wave_sum(s);
        if (lane < 32) ss[(size_t)row * 32 + lane] = (lane == 0) ? s : 0.f;
#pragma unroll
        for (int j = 0; j < 8; ++j) { u32x2 w; w.x = pk2(v[j].x, v[j].y); w.y = pk2(v[j].z, v[j].w); ((u32x2*)(xb + (size_t)row * DM))[64 * j + lane] = w; }
    }
}
__device__ __forceinline__ void final_norm_op(const bf16_t* xb, float* out, const float* g0, const float* ss, int gw, int NGW, int lane) {
    for (int row = gw; row < MTOK; row += NGW) {
        const u32x2* xr = (const u32x2*)(xb + (size_t)row * DM) + lane;
        f32x4* orow = (f32x4*)(out + (size_t)row * DM) + lane;
        const float rstd = rsqrtf(wave_sum(lane < 32 ? ss[(size_t)row * 32 + lane] : 0.f) * (1.f / DM) + 1e-6f);
#pragma unroll
        for (int j = 0; j < 8; ++j) { const u32x2 w = xr[64 * j]; const f32x4 g = ((const f32x4*)g0)[64 * j + lane];
            orow[64 * j] = (f32x4){bflo(w.x), bfhi(w.x), bflo(w.y), bfhi(w.y)} * rstd * g; }
    }
}

#define MFMA32(a, b, c) __builtin_amdgcn_mfma_f32_32x32x16_bf16((a), (b), (c), 0, 0, 0)
__device__ __forceinline__ int crow(int reg, int h) { return (reg & 3) + 8 * (reg >> 2) + 4 * h; }
__device__ __forceinline__ bf16x8 pack8(const f32x16& p, int s) {
    u32x4 w; w.x = pk2(p[8 * s], p[8 * s + 1]); w.y = pk2(p[8 * s + 2], p[8 * s + 3]); w.z = pk2(p[8 * s + 4], p[8 * s + 5]); w.w = pk2(p[8 * s + 6], p[8 * s + 7]);
    return __builtin_bit_cast(bf16x8, w);
}
__device__ __forceinline__ bf16x8 ldv(const bf16_t* p) {
    const u32x2 lo = *(const u32x2*)p, hi = *(const u32x2*)(p + 8);
    u32x4 w; w.x = lo.x; w.y = lo.y; w.z = hi.x; w.w = hi.y; return __builtin_bit_cast(bf16x8, w);
}

__device__ __forceinline__ float swap32_max(float v) { auto rr = __builtin_amdgcn_permlane32_swap(__float_as_uint(v), __float_as_uint(v), false, false); return fmaxf(__uint_as_float(rr[0]), __uint_as_float(rr[1])); }
__device__ __forceinline__ float swap32_sum(float v) { auto rr = __builtin_amdgcn_permlane32_swap(__float_as_uint(v), __float_as_uint(v), false, false); return __uint_as_float(rr[0]) + __uint_as_float(rr[1]); }
template <int NDT, int MODE>
__device__ __forceinline__ void attn_subtile(const LAS unsigned char* Kp, unsigned kfb, const LAS unsigned char* Vp, unsigned vfbs, const bf16x8 (&qf)[8], f32x16 (&O)[NDT],
                                             float& mrun, float& lrun, float sc2, float slope2, int dbase, bool edge) {
    f32x16 S;
#pragma unroll
    for (int i = 0; i < 16; ++i) S[i] = 0.f;
    {
        bf16x8 kf[8];
#pragma unroll
        for (int ks = 0; ks < 8; ++ks) kf[ks] = *(const LAS bf16x8*)(Kp + (kfb ^ (unsigned)(ks << 5)));
#pragma unroll
        for (int ks = 0; ks < 8; ++ks) S = MFMA32(kf[ks], qf[ks], S);
        __builtin_amdgcn_sched_group_barrier(0x100, 4, 0);
#pragma unroll
        for (int ks = 0; ks < 4; ++ks) { __builtin_amdgcn_sched_group_barrier(0x008, 1, 0); __builtin_amdgcn_sched_group_barrier(0x100, 1, 0); }
        __builtin_amdgcn_sched_group_barrier(0x008, 4, 0);
    }
    __builtin_amdgcn_sched_barrier(0);
    const float bb = -slope2 * (float)dbase - mrun;
#pragma unroll
    for (int i = 0; i < 16; ++i) { const int c = 16 * (i >> 3) + (i & 7); S[i] = fmaf(slope2, (float)c, fmaf(S[i], sc2, bb)); }
    if (edge) {
#pragma unroll
        for (int i = 0; i < 16; ++i) { const int dist = dbase - (16 * (i >> 3) + (i & 7));
            const bool ok = (MODE == 1) ? (dist >= 0) : (dist >= 0 && dist <= 128); S[i] = ok ? S[i] : -1e30f; }
    }
    float mx = fmaxf(fmaxf(S[0], S[1]), fmaxf(S[2], S[3]));
#pragma unroll
    for (int i = 4; i < 16; i += 4) mx = fmaxf(mx, fmaxf(fmaxf(S[i], S[i + 1]), fmaxf(S[i + 2], S[i + 3])));
    mx = swap32_max(mx);
    if (__builtin_amdgcn_ballot_w64(mx > 8.0f) != 0ull) {
        const float d = fmaxf(mx, 0.f), alpha = __builtin_amdgcn_exp2f(-d);
        lrun *= alpha; mrun += d;
#pragma unroll
        for (int dt = 0; dt < NDT; ++dt)
#pragma unroll
            for (int i = 0; i < 16; ++i) O[dt][i] *= alpha;
#pragma unroll
        for (int i = 0; i < 16; ++i) S[i] -= d;
    }
    float ps = 0.f;
#pragma unroll
    for (int i = 0; i < 16; ++i) { const float pv = __builtin_amdgcn_exp2f(S[i]); S[i] = pv; ps += pv; }
    lrun += swap32_sum(ps);
    const bf16x8 p0 = pack8(S, 0), p1 = pack8(S, 1);
    __builtin_amdgcn_sched_barrier(0);
    {
        bf16x8 v0[NDT], v1[NDT];
#pragma unroll
        for (int dt = 0; dt < NDT; ++dt) { v0[dt] = *(const LAS bf16x8*)(Vp + dt * 4096 + vfbs); v1[dt] = *(const LAS bf16x8*)(Vp + dt * 4096 + (vfbs ^ 32u)); }
#pragma unroll
        for (int dt = 0; dt < NDT; ++dt) { O[dt] = MFMA32(v0[dt], p0, O[dt]); O[dt] = MFMA32(v1[dt], p1, O[dt]); }
        __builtin_amdgcn_sched_group_barrier(0x100, 6, 0);
#pragma unroll
        for (int k = 0; k < 2 * NDT - 6; ++k) { __builtin_amdgcn_sched_group_barrier(0x008, 1, 0); __builtin_amdgcn_sched_group_barrier(0x100, 1, 0); }
        __builtin_amdgcn_sched_group_barrier(0x008, 6, 0);
    }
    __builtin_amdgcn_sched_barrier(0);
}

#define GLDS16(gp, lp) __builtin_amdgcn_global_load_lds((const unsigned*)(gp), (LAS unsigned*)(lp), 16, 0, 0)
__device__ __forceinline__ int pi32(int rho) { return (rho & 0x13) | ((rho & 4) << 1) | ((rho & 8) >> 1); }
__device__ __forceinline__ void attn_a_op(LAS unsigned char* lds, const bf16_t* QK, const bf16_t* VT, bf16_t* OG, bf16_t* AO, float* LSE, int G, int tid, int g0) {
    const int lane = tid & 63, wave = __builtin_amdgcn_readfirstlane(tid >> 6), r = lane & 31, h2 = lane >> 5;
    const float sc2 = 0.08838834764831845f * LOG2E;
    const int krow = pi32(r);
    const unsigned kfb = (unsigned)(krow * 256 + ((h2 ^ (krow & 15)) << 4));
    const unsigned vfb = (unsigned)(r * 128 + ((h2 ^ ((r >> 1) & 7)) << 4));
    for (int U = g0 * 1024 + (int)blockIdx.x; U < (g0 + 1) * 1024; U += G) {
        const int nb = U & 7, h = (U >> 3) & 15, b = (U >> 7) & 7, g = U >> 10;
        const int L = 2048 >> (2 * g);
        const int R0 = 256 * nb, qpos0 = R0 + 32 * wave, seq0 = qpos0 & ~(L - 1), lo = (qpos0 - 128 > seq0) ? qpos0 - 128 : seq0;
        const int t0 = ((R0 & ~(L - 1)) == R0) ? 2 : 0;
        const float slope2 = exp2f(-0.5f * (float)(h + 1)) * (float)(1 << (2 * g)) * LOG2E;
        const bf16_t* QKg = QK + (size_t)g * MTOK * 4096 + (size_t)(b * 2048) * 4096 + h * 128;
        const char* kg = (const char*)(QKg + 2048) + (ptrdiff_t)(R0 - 128) * (4096 * 2);
        const char* vg = (const char*)(VT + (size_t)g * DM * MTOK) + (ptrdiff_t)((b * 2048 + R0 - 128) >> 6) * 262144 + (size_t)(h * 128) * 128;
        bf16x8 qf[8];
        { const bf16_t* qp = QKg + (size_t)(qpos0 + r) * 4096 + 8 * h2;
#pragma unroll
          for (int ks = 0; ks < 8; ++ks) qf[ks] = *(const bf16x8*)(qp + 16 * ks); }
        f32x16 O[4];
#pragma unroll
        for (int dt = 0; dt < 4; ++dt)
#pragma unroll
            for (int i = 0; i < 16; ++i) O[dt][i] = 0.f;
        float mrun = -64.f, lrun = 0.f;
#define STAGE_A(t_, buf_) do { LAS unsigned char* kb_ = lds + (buf_) * 32768 + wave * 2048; const char* kgt_ = kg + (ptrdiff_t)(t_) * (64 * 4096 * 2); const char* vgt_ = vg + (ptrdiff_t)(t_) * 262144; \
            int ln_ = lane; asm volatile("" : "+v"(ln_)); \
            _Pragma("unroll") for (int i_ = 0; i_ < 2; ++i_) { const int j_ = wave * 2 + i_; \
                const int kr_ = 4 * j_ + (ln_ >> 4), kg_ = (ln_ & 15) ^ (kr_ & 15); GLDS16(kgt_ + (unsigned)(kr_ * 4096 * 2 + kg_ * 16), kb_ + i_ * 1024); \
                const int vr_ = 8 * j_ + (ln_ >> 3), vg_ = (ln_ & 7) ^ ((vr_ >> 1) & 7); GLDS16(vgt_ + ((unsigned)vr_ * 128u + (unsigned)(vg_ * 16)), kb_ + 16384 + i_ * 1024); } } while (0)
        STAGE_A(t0, t0 & 1);
        for (int t = t0; t < 6; ++t) {
            asm volatile("s_waitcnt vmcnt(0)\n\ts_barrier" ::: "memory");
            if (t + 1 < 6) STAGE_A(t + 1, (t + 1) & 1);
            const int kp0 = R0 - 128 + 64 * t;
            if (kp0 + 63 >= lo && kp0 <= qpos0 + 31) {
                const LAS unsigned char* Kb = lds + (t & 1) * 32768; const LAS unsigned char* Vb = Kb + 16384;
#pragma unroll 1
                for (int sub = 0; sub < 2; ++sub) {
                    const int kb0 = kp0 + 32 * sub;
                    if (kb0 + 31 >= lo && kb0 <= qpos0 + 31) {
                        const bool edge = (kb0 + 31 > qpos0) || (kb0 < qpos0 + 31 - 128);
                        attn_subtile<4, 2>(Kb + sub * 8192, kfb, Vb, vfb ^ (unsigned)(sub << 6), qf, O, mrun, lrun, sc2, slope2, qpos0 + r - kb0 - 8 * h2, edge);
                    }
                }
            }
        }
#undef STAGE_A
        const size_t grow = (size_t)(b * 2048 + qpos0 + r);
        if (g != 0) {
            const float inv = 1.f / lrun;
            bf16_t* op = OG + (size_t)g * MTOK * DM + grow * DM + h * 128 + 4 * h2;
#pragma unroll
            for (int dt = 0; dt < 4; ++dt)
#pragma unroll
                for (int q = 0; q < 4; ++q) { u32x2 w; w.x = pk2(O[dt][4 * q] * inv, O[dt][4 * q + 1] * inv); w.y = pk2(O[dt][4 * q + 2] * inv, O[dt][4 * q + 3] * inv);
                    *(u32x2*)(op + 32 * dt + 8 * q) = w; }
            if (h2 == 0) LSE[(size_t)g * MTOK * 16 + grow * 16 + h] = mrun + log2f(lrun);
        } else {
            const int t = qpos0 + r, bb = b * 2048;
            const size_t r1 = (size_t)(bb + (t & 3) * 512 + (t >> 2)), r2 = (size_t)(bb + (t & 15) * 128 + (t >> 4));
            const float e0 = mrun + log2f(lrun), e1 = LSE[(size_t)MTOK * 16 + r1 * 16 + h], e2 = LSE[(size_t)2 * MTOK * 16 + r2 * 16 + h];
            const float mxe = fmaxf(e0, fmaxf(e1, e2));
            float w0 = exp2f(e0 - mxe), w1 = exp2f(e1 - mxe), w2 = exp2f(e2 - mxe);
            const float winv = 1.f / (w0 + w1 + w2); w0 *= winv / lrun; w1 *= winv; w2 *= winv;
            const bf16_t* p1 = OG + (size_t)MTOK * DM + r1 * DM + h * 128 + 4 * h2;
            const bf16_t* p2 = OG + (size_t)2 * MTOK * DM + r2 * DM + h * 128 + 4 * h2;
            bf16_t* op = AO + grow * DM + h * 128 + 4 * h2;
#pragma unroll
            for (int dt = 0; dt < 4; ++dt) {
                u32x2 a[4], c[4];
#pragma unroll
                for (int q = 0; q < 4; ++q) { a[q] = *(const u32x2*)(p1 + 32 * dt + 8 * q); c[q] = *(const u32x2*)(p2 + 32 * dt + 8 * q); }
#pragma unroll
                for (int q = 0; q < 4; ++q) { u32x2 w;
                    w.x = pk2(O[dt][4 * q] * w0 + w1 * bflo(a[q].x) + w2 * bflo(c[q].x), O[dt][4 * q + 1] * w0 + w1 * bfhi(a[q].x) + w2 * bfhi(c[q].x));
                    w.y = pk2(O[dt][4 * q + 2] * w0 + w1 * bflo(a[q].y) + w2 * bflo(c[q].y), O[dt][4 * q + 3] * w0 + w1 * bfhi(a[q].y) + w2 * bfhi(c[q].y));
                    *(u32x2*)(op + 32 * dt + 8 * q) = w; }
                asm volatile("" ::: "memory");
            }
        }
        __syncthreads();
    }
}
__device__ __forceinline__ void merge_op(const bf16_t* OG, const bf16_t* OG0, const float* LSE, bf16_t* AO, int gw, int NGW, int lane) {
    for (int rowp = 2 * gw; rowp < MTOK; rowp += 2 * NGW) {
        u32x4 a[2][4], bq[2][4], cq[2][4]; float w0[2], w1[2], w2[2];
#pragma unroll
        for (int k = 0; k < 2; ++k) {
            const int row = rowp + k, b = row >> 11, t = row & 2047, hd = lane >> 2;
            const int r0 = row, r1 = (b << 11) + (t & 3) * 512 + (t >> 2), r2 = (b << 11) + (t & 15) * 128 + (t >> 4);
            const u32x4* p0 = (const u32x4*)(OG0 + (size_t)r0 * DM + 32 * lane);
            const u32x4* p1 = (const u32x4*)(OG + (size_t)MTOK * DM + (size_t)r1 * DM + 32 * lane);
            const u32x4* p2 = (const u32x4*)(OG + (size_t)2 * MTOK * DM + (size_t)r2 * DM + 32 * lane);
#pragma unroll
            for (int c = 0; c < 4; ++c) { a[k][c] = p0[c]; bq[k][c] = p1[c]; cq[k][c] = p2[c]; }
            const float e0 = LSE[(size_t)r0 * 16 + hd], e1 = LSE[(size_t)MTOK * 16 + (size_t)r1 * 16 + hd], e2 = LSE[(size_t)2 * MTOK * 16 + (size_t)r2 * 16 + hd];
            const float mx = fmaxf(e0, fmaxf(e1, e2));
            float x0 = exp2f(e0 - mx), x1 = exp2f(e1 - mx), x2 = exp2f(e2 - mx);
            const float inv = 1.f / (x0 + x1 + x2); w0[k] = x0 * inv; w1[k] = x1 * inv; w2[k] = x2 * inv;
        }
#pragma unroll
        for (int k = 0; k < 2; ++k) {
            u32x4* po = (u32x4*)(AO + (size_t)(rowp + k) * DM + 32 * lane);
#pragma unroll
            for (int c = 0; c < 4; ++c) { u32x4 o;
#pragma unroll
                for (int j = 0; j < 4; ++j) { const float lo = w0[k] * bflo(a[k][c][j]) + w1[k] * bflo(bq[k][c][j]) + w2[k] * bflo(cq[k][c][j]), hi = w0[k] * bfhi(a[k][c][j]) + w1[k] * bfhi(bq[k][c][j]) + w2[k] * bfhi(cq[k][c][j]); o[j] = pk2(lo, hi); }
                po[c] = o; }
        }
    }
}
__device__ __forceinline__ void attn_b_op(LAS unsigned char* lds, const bf16_t* Q12, const bf16_t* K12, const bf16_t* VTb, const float* lam, const float* subg, bf16_t* AO, int G, int tid) {
    const int lane = tid & 63, wave = __builtin_amdgcn_readfirstlane(tid >> 6), r = lane & 31, h2 = lane >> 5, wq = wave & 3, m = wave >> 2;
    const float sc2 = 0.08838834764831845f * LOG2E;
    const float lambda_init = 0.8f - 0.6f * 0.7408182206817179f;
    float lam_full;
    { const float a = lam[lane] * lam[128 + lane] + lam[64 + lane] * lam[192 + lane], c = lam[256 + lane] * lam[384 + lane] + lam[320 + lane] * lam[448 + lane];
      lam_full = __int_as_float(__builtin_amdgcn_readfirstlane(__float_as_int(__expf(wave_sum(a)) - __expf(wave_sum(c)) + lambda_init))); }
    const int krow = pi32(r);
    const unsigned kfb = (unsigned)(krow * 512 + ((((16 * m + h2) ^ (krow & 15))) << 4));
    const unsigned vfb = (unsigned)(r * 128 + ((h2 ^ ((r >> 1) & 7)) << 4));
    for (int P = blockIdx.x; P < 512; P += G) {
        const int bh = P >> 3, pp = P & 7, b = bh >> 3, h = bh & 7;
        const float slope2 = exp2f(-(float)(h + 1)) * LOG2E;
        const char* kg = (const char*)(K12 + (size_t)(b * 2048) * DM + h * 256);
        const char* vg = (const char*)VTb + (size_t)(b * 32) * 262144 + (size_t)(h * 256) * 128;
        for (int which = 0; which < 2; ++which) {
            const int qb = which ? 15 - pp : pp;
            const int qpos0 = 128 * qb + 32 * wq, nkt = 2 * qb + 2;
            bf16x8 qf[8];
            { const bf16_t* qp = Q12 + (size_t)(b * 2048 + qpos0 + r) * DM + h * 256 + m * 128 + 8 * h2;
#pragma unroll
              for (int ks = 0; ks < 8; ++ks) qf[ks] = *(const bf16x8*)(qp + 16 * ks); }
            f32x16 O[8];
#pragma unroll
            for (int dt = 0; dt < 8; ++dt)
#pragma unroll
                for (int i = 0; i < 16; ++i) O[dt][i] = 0.f;
            float mrun = -64.f, lrun = 0.f;
#define STAGE_B(kt_, buf_) do { LAS unsigned char* kb_ = lds + (buf_) * 65536 + wave * 4096; const char* kgt_ = kg + (size_t)(kt_) * (64 * DM * 2); const char* vgt_ = vg + (size_t)(kt_) * 262144; \
            int ln_ = lane; asm volatile("" : "+v"(ln_)); \
            _Pragma("unroll") for (int i_ = 0; i_ < 4; ++i_) { const int j_ = wave * 4 + i_; \
                const int kr_ = 2 * j_ + (ln_ >> 5), kg_ = (ln_ & 31) ^ (kr_ & 15); GLDS16(kgt_ + (unsigned)(kr_ * DM * 2 + kg_ * 16), kb_ + i_ * 1024); \
                const int vr_ = 8 * j_ + (ln_ >> 3), vg_ = (ln_ & 7) ^ ((vr_ >> 1) & 7); GLDS16(vgt_ + ((unsigned)vr_ * 128u + (unsigned)(vg_ * 16)), kb_ + 32768 + i_ * 1024); } } while (0)
            STAGE_B(0, 0);
            for (int kt = 0; kt < nkt; ++kt) {
                asm volatile("s_waitcnt vmcnt(0)\n\ts_barrier" ::: "memory");
                if (kt + 1 < nkt) STAGE_B(kt + 1, (kt + 1) & 1);
                if (64 * kt <= qpos0 + 31) {
                    const LAS unsigned char* Kb = lds + (kt & 1) * 65536; const LAS unsigned char* Vb = Kb + 32768;
                    const bool diag = (64 * kt + 63 > qpos0);
#pragma unroll 1
                    for (int sub = 0; sub < 2; ++sub) {
                        const int kb0 = 64 * kt + 32 * sub;
                        if (kb0 <= qpos0 + 31) {
                            attn_subtile<8, 1>(Kb + sub * 16384, kfb, Vb, vfb ^ (unsigned)(sub << 6), qf, O, mrun, lrun, sc2, slope2, qpos0 + r - kb0 - 8 * h2, diag);
                        }
                    }
                }
            }
#undef STAGE_B
            const float scl = (m == 0) ? (1.f / lrun) : (lam_full / lrun);
            __syncthreads();
            LAS float* xme = (LAS float*)(lds + wave * 16384) + lane;
            const LAS float* xpa = (const LAS float*)(lds + (wave ^ 4) * 16384) + lane;
            LAS float* ssx = (LAS float*)(lds + 131072);
            if (m == 0) {
#pragma unroll
                for (int dtl = 0; dtl < 4; ++dtl)
#pragma unroll
                    for (int i = 0; i < 16; ++i) xme[(dtl * 16 + i) * 64] = O[4 + dtl][i] * scl;
            } else {
#pragma unroll
                for (int dtl = 0; dtl < 4; ++dtl)
#pragma unroll
                    for (int i = 0; i < 16; ++i) xme[(dtl * 16 + i) * 64] = O[dtl][i] * scl;
            }
            __syncthreads();
            float ss = 0.f;
            if (m == 0) {
#pragma unroll
                for (int dtl = 0; dtl < 4; ++dtl)
#pragma unroll
                    for (int i = 0; i < 16; ++i) { const float o = O[dtl][i] * scl - xpa[(dtl * 16 + i) * 64]; O[dtl][i] = o; ss += o * o; }
            } else {
#pragma unroll
                for (int dtl = 0; dtl < 4; ++dtl)
#pragma unroll
                    for (int i = 0; i < 16; ++i) { const float o = xpa[(dtl * 16 + i) * 64] - O[4 + dtl][i] * scl; O[dtl][i] = o; ss += o * o; }
            }
            ss += __shfl_xor(ss, 32);
            if (h2 == 0) ssx[wave * 32 + r] = ss;
            __syncthreads();
            ss += ssx[(wave ^ 4) * 32 + r];
            const float rn = rsqrtf(ss * (1.f / 256.f) + 1e-5f) * (1.f - lambda_init);
            bf16_t* op = AO + (size_t)(b * 2048 + qpos0 + r) * DM + h * 256 + m * 128 + 4 * h2;
            const float* gp = subg + m * 128 + 4 * h2;
#pragma unroll
            for (int dtl = 0; dtl < 4; ++dtl)
#pragma unroll
                for (int q = 0; q < 4; ++q) { const f32x4 gg = *(const f32x4*)(gp + 32 * dtl + 8 * q);
                    u32x2 w; w.x = pk2(O[dtl][4 * q] * rn * gg.x, O[dtl][4 * q + 1] * rn * gg.y); w.y = pk2(O[dtl][4 * q + 2] * rn * gg.z, O[dtl][4 * q + 3] * rn * gg.w);
                    *(u32x2*)(op + 32 * dtl + 8 * q) = w; }
            __syncthreads();
        }
    }
}


#define XB_TMO      128
#define XB_XCNT(j)  (256  + 64 * (j))
#define XB_XSUB(j)  (1280 + 64 * (j))
#define XB_XGEN(j)  (2304 + 64 * (j))
#define XB_TOP      3328
#define XB_TOPGEN   3392
#define XCD_BAR_WORDS 3456
#define XB_SPIN_CAP (1u << 22)
__device__ __forceinline__ unsigned xb_ld(unsigned* p)              { return __hip_atomic_load(p, __ATOMIC_RELAXED, __HIP_MEMORY_SCOPE_AGENT); }
__device__ __forceinline__ unsigned xb_add(unsigned* p, unsigned v) { return __hip_atomic_fetch_add(p, v, __ATOMIC_RELAXED, __HIP_MEMORY_SCOPE_AGENT); }
__device__ __forceinline__ unsigned xb_xcc_id() { return (unsigned)__builtin_amdgcn_s_getreg((3 << 11) | 20) & 0xFu; }
#define XB_SPIN(cond, bar) do { unsigned _sp = 0; while (cond) { __builtin_amdgcn_s_sleep(1); \
    if ((++_sp & 255u) == 0u) { if (xb_ld(&(bar)[XB_TMO])) break; if (_sp > XB_SPIN_CAP) { atomicAdd(&(bar)[XB_TMO], 1u); break; } } } } while (0)
__device__ __forceinline__ void xcd_barrier_complete(unsigned* bar, unsigned x, unsigned& nloc, unsigned& nx) {
    const unsigned G = gridDim.x * gridDim.y * gridDim.z;
    unsigned sum, cnt, mine, sp = 0u;
    for (;;) {
        sum = 0u; cnt = 0u; mine = 0u;
#pragma unroll
        for (unsigned j = 0; j < 16; ++j) { const unsigned c = xb_ld(&bar[XB_XCNT(j)]); sum += c; cnt += (c > 0u) ? 1u : 0u; mine = (j == x) ? c : mine; }
        if (sum == G) break;
        __builtin_amdgcn_s_sleep(1);
        if ((++sp & 255u) == 0u) { if (xb_ld(&bar[XB_TMO])) break; if (sp > XB_SPIN_CAP) { atomicAdd(&bar[XB_TMO], 1u); break; } }
    }
    nloc = mine > 0u ? mine : 1u; nx = cnt > 0u ? cnt : 1u;
}
__device__ __forceinline__ void xcd_barrier(unsigned* bar, volatile LAS unsigned* st) {
    asm volatile("s_waitcnt vmcnt(0)" ::: "memory");
    __syncthreads();
    if (threadIdx.x == 0) {
        const unsigned x = xb_xcc_id();
        __builtin_amdgcn_s_waitcnt(0);
        unsigned nloc = st[0], nx = st[1];
        if (nloc == 0u) { xcd_barrier_complete(bar, x, nloc, nx); st[0] = nloc; st[1] = nx; }
        const unsigned old = xb_add(&bar[XB_XSUB(x)], 1u);
        const unsigned gen = old / nloc;
        if (old + 1u == (gen + 1u) * nloc) {
            __builtin_amdgcn_fence(__ATOMIC_RELEASE, "agent");
            asm volatile("s_waitcnt vmcnt(0)" ::: "memory");
            const unsigned og = xb_add(&bar[XB_TOP], 1u);
            const unsigned tg = og / nx;
            if (og + 1u == (tg + 1u) * nx) xb_add(&bar[XB_TOPGEN], 1u);
            else XB_SPIN(xb_ld(&bar[XB_TOPGEN]) == tg, bar);
            __builtin_amdgcn_fence(__ATOMIC_ACQUIRE, "agent");
            xb_add(&bar[XB_XGEN(x)], 1u);
            asm volatile("s_waitcnt vmcnt(0)" ::: "memory");
        } else {
            XB_SPIN(xb_ld(&bar[XB_XGEN(x)]) == gen, bar);
            __builtin_amdgcn_fence(__ATOMIC_ACQUIRE, "agent");
            asm volatile("s_waitcnt vmcnt(0)" ::: "memory");
        }
    }
    __syncthreads();
}

struct Args { const float* in[13]; float* out; unsigned char* ws; int lo, hi; };
constexpr int N_OPS = 26;
struct OpD { int kind, sync; unsigned long long a_off, b_off, o_off; int M, N, ld, i0, ss_in, ss_out, mode; float scale; };
#define WS_H WS_BIG
#define SS(k) ((int)(WS_SSP + (size_t)(k) * 2 * MiB))
__device__ const OpD OPS[N_OPS] = {
      {0, 0, 0, 0, 0, 0, 0, 0, 0, 0, 0, 0, 0.f},
      {1, 1, 0, 0, 0, 0, 0, 0, 0, 0, SS(0), 0, 0.f},
      {2, 1, WS_XN, WS_WIN + 0 * SZ_WIN, WS_H, MTOK, 2 * FF, FF, 0, SS(0), 0, 0, 0.f},
      {3, 1, WS_H, WS_WOUT + 0 * SZ_WOUT, WS_XN, MTOK, DM, DM, 0, (int)WS_XN, SS(1), 1, 0.5f},
      {4, 0, WS_XN + 1 * SZ_XN, WS_WA + (size_t)1 * 6144 * DM * 2, WS_BIG + 1 * SZ_QK, MTOK, 4096, 4096, 0, SS(1), 0, 1, 0.f},
      {4, 1, WS_WA + (size_t)(1 * 6144 + 4096) * DM * 2, WS_XN + 1 * SZ_XN, WS_VT + 1 * SZ_XN, DM, MTOK, MTOK, 0, SS(1), 0, 4, 0.f},
      {5, 0, 0, 0, 0, 0, 0, 0, 0, 0, 0, 1, 0.f},
      {4, 0, WS_XN + 2 * SZ_XN, WS_WA + (size_t)2 * 6144 * DM * 2, WS_BIG + 2 * SZ_QK, MTOK, 4096, 4096, 0, SS(1), 0, 2, 0.f},
      {4, 1, WS_WA + (size_t)(2 * 6144 + 4096) * DM * 2, WS_XN + 2 * SZ_XN, WS_VT + 2 * SZ_XN, DM, MTOK, MTOK, 0, SS(1), 0, 5, 0.f},
      {5, 0, 0, 0, 0, 0, 0, 0, 0, 0, 0, 2, 0.f},
      {4, 0, WS_XN + 0 * SZ_XN, WS_WA + (size_t)0 * 6144 * DM * 2, WS_BIG + 0 * SZ_QK, MTOK, 4096, 4096, 0, SS(1), 0, 0, 0.f},
      {4, 1, WS_WA + (size_t)(0 * 6144 + 4096) * DM * 2, WS_XN + 0 * SZ_XN, WS_VT + 0 * SZ_XN, DM, MTOK, MTOK, 0, SS(1), 0, 3, 0.f},
      {5, 1, 0, 0, 0, 0, 0, 0, 0, 0, 0, 0, 0.f},
      {9, 1, WS_AO, WS_WOA, WS_XN, MTOK, DM, DM, -1, (int)WS_XN, SS(2), 0, 1.0f},
      {2, 1, WS_XN, WS_WIN + 1 * SZ_WIN, WS_H, MTOK, 2 * FF, FF, 0, SS(2), 0, 0, 0.f},
      {3, 1, WS_H, WS_WOUT + 1 * SZ_WOUT, WS_XN, MTOK, DM, DM, -1, (int)WS_XN, SS(3), 0, 0.5f},
      {2, 1, WS_XN, WS_WIN + 2 * SZ_WIN, WS_H, MTOK, 2 * FF, FF, 0, SS(3), 0, 0, 0.f},
      {3, 1, WS_H, WS_WOUT + 2 * SZ_WOUT, WS_XN + SZ_XN, MTOK, DM, DM, -1, (int)WS_XN, SS(4), 0, 0.5f},
      {4, 0, WS_XN + SZ_XN, WS_WQ, WS_VT + 2 * SZ_XN, MTOK, DM, DM, 0, SS(4), 0, 0, 0.f},
      {4, 0, WS_XN, WS_WKV, WS_VT + 0 * SZ_XN, MTOK, DM, DM, 0, SS(3), 0, 0, 0.f},
      {4, 1, WS_WKV + (size_t)DM * DM * 2, WS_XN, WS_VT + 1 * SZ_XN, DM, MTOK, MTOK, 0, SS(3), 0, 3, 0.f},
      {7, 1, 0, 0, 0, 0, 0, 0, 0, 0, 0, 0, 0.f},
      {9, 1, WS_AO, WS_WOB, WS_XN + SZ_XN, MTOK, DM, DM, -1, (int)(WS_XN + SZ_XN), SS(5), 0, 1.0f},
      {2, 1, WS_XN + SZ_XN, WS_WIN + 3 * SZ_WIN, WS_H, MTOK, 2 * FF, FF, 0, SS(5), 0, 0, 0.f},
      {3, 1, WS_H, WS_WOUT + 3 * SZ_WOUT, WS_XN + SZ_XN, MTOK, DM, DM, -1, (int)(WS_XN + SZ_XN), SS(6), 0, 0.5f},
      {8, 0, WS_XN + SZ_XN, 0, 0, 0, 0, 0, 0, SS(6), 0, 0, 0.f},
};

__global__ void __launch_bounds__(NTHREADS, 2) fwd(Args args) {
    extern __shared__ __attribute__((aligned(16))) unsigned char lds_raw[];
    LAS unsigned char* lds = (LAS unsigned char*)lds_raw;
    const int G = gridDim.x, NGW = G * NWAVES;
    volatile LAS unsigned* bst = (volatile LAS unsigned*)(lds + LDS_BYTES - 256);
    if (threadIdx.x < 2) bst[threadIdx.x] = 0u;
    if (threadIdx.x == 0) (void)xb_add((unsigned*)args.ws + XB_XCNT(xb_xcc_id()), 1u);
    __syncthreads();

    for (int op = args.lo; op < args.hi; ++op) {
        const OpD d = OPS[op];
        for (int rep = 0; rep < ((op == REP_OP) ? REP_N : 1); ++rep) {
        int tid = threadIdx.x; asm volatile("" : "+v"(tid));
        const int lane = tid & 63, wave = __builtin_amdgcn_readfirstlane(tid >> 6), gw = blockIdx.x * NWAVES + wave;
        unsigned char* ws = args.ws;
        float* X = args.out;
        if (d.kind == 0) {
            LAS float* scr = (LAS float*)(lds + wave * 16640);
            const float* w_in = args.in[2]; const float* gains = args.in[1];
            for (int f = 0; f < 4; ++f) conv_matrix(w_in + (size_t)f * DM * 2 * FF, DM, 2 * FF, (bf16_t*)(ws + WS_WIN) + (size_t)f * 2 * FF * DM, 1, scr, gw, NGW, lane, gains + ((f >> 1) * 3 + (f & 1) * 2) * DM);
            conv_matrix(args.in[4], DM, 18432, (bf16_t*)(ws + WS_WA), 2, scr, gw, NGW, lane, gains + 1 * DM);
            conv_matrix(args.in[5], DM, DM, (bf16_t*)(ws + WS_WOA), 0, scr, gw, NGW, lane, nullptr);
            conv_matrix(args.in[7], DM, 4096, (bf16_t*)(ws + WS_WKV), 0, scr, gw, NGW, lane, args.in[6]);
            conv_matrix(args.in[8], DM, DM, (bf16_t*)(ws + WS_WQ), 0, scr, gw, NGW, lane, gains + 4 * DM);
            conv_matrix(args.in[11], DM, DM, (bf16_t*)(ws + WS_WOB), 0, scr, gw, NGW, lane, nullptr);
            __syncthreads();
        } else if (d.kind == 1) {
            prep_op(args.in[0], (bf16_t*)(ws + WS_XN), (float*)(ws + d.ss_out), gw, NGW, lane);
        } else if (d.kind == 2) {
            pg8::Gemm gm{(const bf16_t*)(ws + d.a_off), (const bf16_t*)(ws + d.b_off), d.M, d.N, DM};
            pg8::StaticOrder S; S.init(gm.M, gm.N, G, (int)blockIdx.x);
            pg8::EpiSwiGLU E{(bf16_t*)(ws + d.o_off), FF, (const float*)(ws + d.ss_in)};
            pg8::gemm_phase<DM, pg8::EpiSwiGLU, pg8::StaticOrder, true, true>(lds, gm, S, E, tid);
            if (G == 256 ? (int)blockIdx.x >= 192 : true) {
                const int tw = (G == 256) ? ((int)blockIdx.x - 192) * NWAVES + wave : gw, TW = (G == 256) ? 64 * NWAVES : NGW;
                LAS float* scr = (LAS float*)(lds + wave * 16640);
                const float* w_out = args.in[3];
                const int f = (int)((d.b_off - WS_WIN) / SZ_WIN);
                conv_matrix(w_out + (size_t)f * FF * DM, FF, DM, (bf16_t*)(ws + WS_WOUT) + (size_t)f * DM * FF, 0, scr, tw, TW, lane, nullptr);
            }
        } else if (d.kind == 3) {
            pg8::Gemm gm{(const bf16_t*)(ws + d.a_off), (const bf16_t*)(ws + d.b_off), d.M, d.N, FF};
            pg8::StaticOrder S; S.init(gm.M, gm.N, G, (int)blockIdx.x, 4);
            pg8::EpiResid E{X, DM, d.scale, (bf16_t*)(ws + d.o_off), (float*)(ws + d.ss_out), d.mode & 1, d.mode >> 1, (const bf16_t*)(ws + (size_t)d.ss_in)};
            pg8::gemm_phase<FF, pg8::EpiResid, pg8::StaticOrder, true, true>(lds, gm, S, E, tid);
        } else if (d.kind == 9) {
            pg8::Gemm gm{(const bf16_t*)(ws + d.a_off), (const bf16_t*)(ws + d.b_off), d.M, d.N, DM};
            pg8::StaticOrder S; S.init(gm.M, gm.N, G, (int)blockIdx.x, 4);
            pg8::EpiResid E{X, DM, d.scale, (bf16_t*)(ws + d.o_off), (float*)(ws + d.ss_out), 0, 0, (const bf16_t*)(ws + (size_t)d.ss_in)};
            pg8::gemm_phase<DM, pg8::EpiResid, pg8::StaticOrder, true, true>(lds, gm, S, E, tid);
        } else if (d.kind == 4) {
            pg8::Gemm gm{(const bf16_t*)(ws + d.a_off), (const bf16_t*)(ws + d.b_off), d.M, d.N, DM};
            pg8::StaticOrder S; S.init(gm.M, gm.N, G, (int)blockIdx.x);
            pg8::EpiBf16 E{(bf16_t*)(ws + d.o_off), d.ld, (const float*)(ws + d.ss_in), d.mode};
            pg8::gemm_phase<DM, pg8::EpiBf16, pg8::StaticOrder, true, true>(lds, gm, S, E, tid);
        } else if (d.kind == 5) {
            attn_a_op(lds, (const bf16_t*)(ws + WS_BIG), (const bf16_t*)(ws + WS_VT), (bf16_t*)(ws + WS_XN), (bf16_t*)(ws + WS_AO), (float*)(ws + WS_LSE), G, tid, d.mode);
        } else if (d.kind == 6) {
            merge_op((const bf16_t*)(ws + WS_XN), (const bf16_t*)(ws + WS_OG0), (const float*)(ws + WS_LSE), (bf16_t*)(ws + WS_AO), gw, NGW, lane);
        } else if (d.kind == 7) {
            attn_b_op(lds, (const bf16_t*)(ws + WS_VT + 2 * SZ_XN), (const bf16_t*)(ws + WS_VT), (const bf16_t*)(ws + WS_VT + SZ_XN), args.in[9], args.in[10], (bf16_t*)(ws + WS_AO), G, tid);
        } else {
            final_norm_op((const bf16_t*)(ws + d.a_off), X, args.in[12], (const float*)(ws + d.ss_in), gw, NGW, lane);
        }
        if (d.sync && op + 1 < args.hi) { if (args.hi > 1000) cg::this_grid().sync(); else xcd_barrier((unsigned*)args.ws, bst); }
        if (SYNC_EXTRA > 0 && op == 1 && op + 1 < args.hi) for (int e = 0; e < SYNC_EXTRA; ++e) xcd_barrier((unsigned*)args.ws, bst);
        }
    }
}

extern "C" void kernel_launch(void* const* d_in, const int* in_sizes, int n_in, void* d_out, int out_size, void* d_ws, size_t ws_size, hipStream_t stream) {
    static int grid = 0;
    if (grid == 0) {
        if (n_in != 13 || out_size != MTOK * DM || ws_size < WS_END) { fprintf(stderr, "kernel_launch: unexpected shapes: n_in %d out %d ws %zu (need %zu)\n", n_in, out_size, ws_size, (size_t)WS_END); grid = -1; return; }
        int dev = 0, cus = 0, per_cu = 0;
        (void)hipGetDevice(&dev); (void)hipDeviceGetAttribute(&cus, hipDeviceAttributeMultiprocessorCount, dev);
        if (hipFuncSetAttribute((const void*)fwd, hipFuncAttributeMaxDynamicSharedMemorySize, LDS_BYTES) != hipSuccess) { fprintf(stderr, "kernel_launch: hipFuncSetAttribute failed\n"); grid = -1; return; }
        if (hipOccupancyMaxActiveBlocksPerMultiprocessor(&per_cu, (const void*)fwd, NTHREADS, LDS_BYTES) != hipSuccess || per_cu < 1) { fprintf(stderr, "kernel_launch: occupancy query says %d\n", per_cu); per_cu = 1; }
        (void)hipGetLastError();
        grid = cus * per_cu;
    }
    if (grid < 0) return;
    (void)hipMemsetAsync(d_ws, 0, 16384, stream);
    Args a{};
    for (int i = 0; i < 13; ++i) a.in[i] = (const float*)d_in[i];
    a.out = (float*)d_out; a.ws = (unsigned char*)d_ws;
#if ONE_LAUNCH
    a.lo = 0; a.hi = N_OPS;
    void* params[] = {&a};
    hipError_t e = hipLaunchCooperativeKernel((const void*)fwd, dim3(grid), dim3(NTHREADS), params, LDS_BYTES, stream);
    if (e != hipSuccess) fprintf(stderr, "cooperative launch failed: %s (grid %d)\n", hipGetErrorString(e), grid);
#else
    for (int op = 0; op < N_OPS; ++op) { a.lo = op; a.hi = op + 1; hipLaunchKernelGGL(fwd, dim3(grid), dim3(NTHREADS), LDS_BYTES, stream, a); }
#endif
}
```

```cpp
#include <hip/hip_runtime.h>
#include <hip/hip_cooperative_groups.h>
#include <cstdio>
#include <cstdint>
namespace cg = cooperative_groups;

#ifndef ONE_LAUNCH
#define ONE_LAUNCH 1
#endif
#ifndef REP_OP
#define REP_OP -1
#define REP_N 1
#endif
#ifndef SYNC_EXTRA
#define SYNC_EXTRA 0
#endif

#define LAS __attribute__((address_space(3)))
typedef unsigned short bf16_t;
typedef short bf16x8 __attribute__((ext_vector_type(8)));
typedef float f32x4 __attribute__((ext_vector_type(4)));
typedef float f32x16 __attribute__((ext_vector_type(16)));
typedef unsigned u32x4 __attribute__((ext_vector_type(4)));
typedef unsigned u32x2 __attribute__((ext_vector_type(2)));
typedef float f32x2_t __attribute__((ext_vector_type(2)));
typedef __bf16 bf16x2_t __attribute__((ext_vector_type(2)));

constexpr int MTOK = 16384, DM = 2048, FF = 5504, SEQ = 2048;
constexpr int NWAVES = 8, NTHREADS = 512;
constexpr int LDS_BYTES = 147456;
constexpr float LOG2E = 1.4426950408889634f;

__device__ __forceinline__ unsigned pk2(float lo, float hi) { f32x2_t v = {lo, hi}; bf16x2_t b = __builtin_convertvector(v, bf16x2_t); return __builtin_bit_cast(unsigned, b); }
__device__ __forceinline__ float bflo(unsigned u) { return __uint_as_float(u << 16); }
__device__ __forceinline__ float bfhi(unsigned u) { return __uint_as_float(u & 0xffff0000u); }
__device__ __forceinline__ float wave_sum(float v) {
#pragma unroll
    for (int o = 1; o < 64; o <<= 1) v += __shfl_xor(v, o);
    return v;
}
#define LDS_WAIT() asm volatile("s_waitcnt lgkmcnt(0)" ::: "memory")

namespace pg8 {
constexpr int MTOK_ = 16384; constexpr int BM = 256, BK = 64, HALF = 128, HTB = HALF * BK * 2, STAGE_BYTES = 8 * HTB, NXCD = 8, WGM = 8;
__host__ __device__ __forceinline__ int lds_byte(int r, int c) { const int st = (r >> 4) * 2 + (c >> 5), rr = r & 15, cc = c & 31, ob = rr * 64 + cc * 2; return st * 1024 + (ob ^ (((ob >> 9) & 1) << 5)); }
__host__ __device__ __forceinline__ void stage_rc(int b, int& R, int& C) { const int st = b / 1024, sb = b % 1024, swz = sb ^ (((sb >> 9) & 1) << 5); R = (st >> 1) * 16 + swz / 64; C = (st & 1) * 32 + (swz % 64) / 2; }
__host__ __device__ __forceinline__ int perm32(int rho) { const int n = rho >> 4, i = rho & 15; return 8 * (i >> 2) + 4 * n + (i & 3); }

struct Unit { int pm, pn; };
struct Gemm { const bf16_t* A; const bf16_t* Bt; int M, N, K; };

struct StaticOrder {
    int nM, nN, nwg, G, c, wgm;
    __device__ void init(int M, int N, int G_, int c_, int wgm_ = WGM) { nM = M / BM; nN = N / BM; nwg = nM * nN; G = G_; c = c_; wgm = wgm_; }
    __device__ bool next(int i, Unit& u) const {
        const long L = (long)i * G + c; if (L >= nwg) return false;
        int wgid = (int)L; { const int q = nwg / NXCD, r = nwg % NXCD, xcd = wgid % NXCD, off = wgid / NXCD; wgid = (xcd < r ? xcd * (q + 1) : r * (q + 1) + (xcd - r) * q) + off; }
        const int nig = wgm * nN, gid = wgid / nig, fm = gid * wgm, gsz = (nM - fm) < wgm ? (nM - fm) : wgm;
        u.pm = fm + ((wgid % nig) % gsz); u.pn = (wgid % nig) / gsz; return true;
    }
};

__device__ __forceinline__ int inv_perm(int idx, int pm) {
    const int pr = idx & 2047, bb = idx & ~2047;
    return pm == 0 ? idx : (pm == 1 ? bb + (pr & 511) * 4 + (pr >> 9) : bb + (pr & 127) * 16 + (pr >> 7));
}
__device__ __forceinline__ float rstd_row(const float* ss, int tok, int fq) {
    const f32x4 a = *(const f32x4*)(ss + (size_t)tok * 32 + fq * 8), b = *(const f32x4*)(ss + (size_t)tok * 32 + fq * 8 + 4);
    float p = ((a[0] + a[1]) + (a[2] + a[3])) + ((b[0] + b[1]) + (b[2] + b[3]));
    p += __shfl_xor(p, 16); p += __shfl_xor(p, 32);
    return rsqrtf(p * (1.f / 2048.f) + 1e-6f);
}
__device__ __forceinline__ float rstd_full(const float* ss, int tok) {
    float p = 0.f;
#pragma unroll
    for (int k = 0; k < 8; ++k) { const f32x4 a = *(const f32x4*)(ss + (size_t)tok * 32 + 4 * k); p += (a[0] + a[1]) + (a[2] + a[3]); }
    return rsqrtf(p * (1.f / 2048.f) + 1e-6f);
}
struct EpiBf16 {
    static constexpr bool PERM = true;
    bf16_t* O; int ldc; const float* ss; int mode;
    __device__ __forceinline__ void operator()(const f32x4 (&acc)[2][2][4][2], const Unit& u, int wr, int wc, int fr, int fq) const {
        const int row0 = u.pm * BM + wr * 64 + fr, col0 = u.pn * BM + wc * 32 + 8 * fq;
        if (mode < 3) {
#pragma unroll
            for (int ai = 0; ai < 2; ++ai)
#pragma unroll
                for (int m = 0; m < 4; ++m) { const int row = row0 + ai * HALF + m * 16; const float rs = rstd_row(ss, inv_perm(row, mode), fq);
                    bf16_t* rowp = O + (size_t)row * ldc + col0;
#pragma unroll
                    for (int bj = 0; bj < 2; ++bj) { const f32x4 v0 = acc[ai][bj][m][0] * rs, v1 = acc[ai][bj][m][1] * rs;
                        u32x4 w; w.x = pk2(v0[0], v0[1]); w.y = pk2(v0[2], v0[3]); w.z = pk2(v1[0], v1[1]); w.w = pk2(v1[2], v1[3]);
                        *(u32x4*)(rowp + bj * HALF) = w; } }
        } else {
            f32x4 cs[2][2];
            const float mine = rstd_full(ss, inv_perm(col0 + (fr >> 3) * HALF + (fr & 7), mode - 3));
#pragma unroll
            for (int bj = 0; bj < 2; ++bj)
#pragma unroll
                for (int n = 0; n < 2; ++n)
#pragma unroll
                    for (int j = 0; j < 4; ++j) cs[bj][n][j] = __shfl(mine, fq * 16 + bj * 8 + n * 4 + j);
#pragma unroll
            for (int ai = 0; ai < 2; ++ai)
#pragma unroll
                for (int m = 0; m < 4; ++m) { const int row = row0 + ai * HALF + m * 16;
#pragma unroll
                    for (int bj = 0; bj < 2; ++bj) { const f32x4 v0 = acc[ai][bj][m][0] * cs[bj][0], v1 = acc[ai][bj][m][1] * cs[bj][1];
                        u32x4 w; w.x = pk2(v0[0], v0[1]); w.y = pk2(v0[2], v0[3]); w.z = pk2(v1[0], v1[1]); w.w = pk2(v1[2], v1[3]);
                        const int c = col0 + bj * HALF;
                        *(u32x4*)(O + ((size_t)(c >> 6) * 2048 + row) * 64 + (c & 63)) = w; } }
        }
    }
};
__device__ __forceinline__ float swiglu1(float g, float up) { return g * __builtin_amdgcn_rcpf(1.0f + __expf(-g)) * up; }
struct EpiSwiGLU {
    static constexpr bool PERM = true;
    bf16_t* O; int ldc; const float* ss;
    __device__ __forceinline__ void operator()(const f32x4 (&acc)[2][2][4][2], const Unit& u, int wr, int wc, int fr, int fq) const {
        const int row0 = u.pm * BM + wr * 64 + fr, col0 = u.pn * HALF + wc * 32 + 8 * fq;
#pragma unroll
        for (int ai = 0; ai < 2; ++ai)
#pragma unroll
            for (int m = 0; m < 4; ++m) { const int row = row0 + ai * HALF + m * 16; const float rs = rstd_row(ss, row, fq);
                bf16_t* rowp = O + (size_t)row * ldc + col0;
                const f32x4 g0 = acc[ai][0][m][0] * rs, g1 = acc[ai][0][m][1] * rs, u0 = acc[ai][1][m][0] * rs, u1 = acc[ai][1][m][1] * rs;
                u32x4 w;
                w.x = pk2(swiglu1(g0[0], u0[0]), swiglu1(g0[1], u0[1])); w.y = pk2(swiglu1(g0[2], u0[2]), swiglu1(g0[3], u0[3]));
                w.z = pk2(swiglu1(g1[0], u1[0]), swiglu1(g1[1], u1[1])); w.w = pk2(swiglu1(g1[2], u1[2]), swiglu1(g1[3], u1[3]));
                *(u32x4*)rowp = w; }
    }
};
struct EpiResid {
    static constexpr bool PERM = true;
    float* out; int ldc; float scale; bf16_t* xb; float* ss; int perm; int f32out; const bf16_t* xin;
    __device__ __forceinline__ void operator()(const f32x4 (&acc)[2][2][4][2], const Unit& u, int wr, int wc, int fr, int fq) const {
        const int row0 = u.pm * BM + wr * 64 + fr, col0 = u.pn * BM + wc * 32 + 8 * fq;
#pragma unroll
        for (int ai = 0; ai < 2; ++ai) {
            u32x4 bs[4][2];
#pragma unroll
            for (int m = 0; m < 4; ++m)
#pragma unroll
                for (int bj = 0; bj < 2; ++bj) bs[m][bj] = *(const u32x4*)(xin + (size_t)(row0 + ai * HALF + m * 16) * ldc + col0 + bj * HALF);
#pragma unroll
            for (int m = 0; m < 4; ++m) { const int row = row0 + ai * HALF + m * 16; const size_t off = (size_t)row * ldc + col0;
                const int bb = row & ~2047, t = row & 2047;
                const size_t o4 = (size_t)(bb + (t & 3) * 512 + (t >> 2)) * ldc + col0, o16 = (size_t)(bb + (t & 15) * 128 + (t >> 4)) * ldc + col0;
                float sq = 0.f;
#pragma unroll
                for (int bj = 0; bj < 2; ++bj) { const u32x4 b = bs[m][bj];
                    const f32x4 v0 = (f32x4){bflo(b.x), bfhi(b.x), bflo(b.y), bfhi(b.y)} + acc[ai][bj][m][0] * scale;
                    const f32x4 v1 = (f32x4){bflo(b.z), bfhi(b.z), bflo(b.w), bfhi(b.w)} + acc[ai][bj][m][1] * scale;
                    sq += ((v0[0] * v0[0] + v0[1] * v0[1]) + (v0[2] * v0[2] + v0[3] * v0[3])) + ((v1[0] * v1[0] + v1[1] * v1[1]) + (v1[2] * v1[2] + v1[3] * v1[3]));
                    u32x4 w; w.x = pk2(v0[0], v0[1]); w.y = pk2(v0[2], v0[3]); w.z = pk2(v1[0], v1[1]); w.w = pk2(v1[2], v1[3]);
                    *(u32x4*)(xb + off + bj * HALF) = w;
                    if (perm) { *(u32x4*)(xb + (size_t)MTOK_ * ldc + o4 + bj * HALF) = w; *(u32x4*)(xb + (size_t)2 * MTOK_ * ldc + o16 + bj * HALF) = w; }
                    if (f32out) { *(f32x4*)(out + off + bj * HALF) = v0; *(f32x4*)(out + off + bj * HALF + 4) = v1; } }
                sq += __shfl_xor(sq, 16); sq += __shfl_xor(sq, 32);
                if (fq == 0) ss[(size_t)row * 32 + u.pn * 4 + wc] = sq; }
            asm volatile("" ::: "memory");
        }
    }
};

template <int K, class Epi, class Sched, bool ALIGN_EPI, bool SP2>
__device__ __forceinline__ void gemm_phase(LAS unsigned char* lds, const Gemm g, const Sched& S, const Epi& E, const int tid) {
    const int wid = __builtin_amdgcn_readfirstlane(tid >> 6), lane = tid & 63, wr = wid >> 2, wc = wid & 3, fr = lane & 15, fq = lane >> 4;
    constexpr int nt = K / BK;
    unsigned voffA[2], voffB[2];
#pragma unroll
    for (int i = 0; i < 2; ++i) { int R, C; stage_rc(tid * 16 + i * 8192, R, C); const int Rb = Epi::PERM ? ((R & ~31) + perm32(R & 31)) : R;
        voffA[i] = (unsigned)(R * K + C) * 2u; voffB[i] = (unsigned)(Rb * K + C) * 2u; }
    const size_t kstep = (size_t)(BK * 2);
    const size_t hstep = (size_t)HALF * K * 2;
    const size_t tstep = 2 * hstep;
    const unsigned ldsw = (unsigned)wid * 1024u;
    const int aoff = lds_byte(wr * 64 + fr, fq * 8), boff = lds_byte(wc * 32 + fr, fq * 8);
#define PG8_SA(b, h) (((b) * 2 + (h)) * HTB)
#define PG8_SB(b, h) ((4 + (b) * 2 + (h)) * HTB)
#define PG8_STAGE(bufoff, gbase, voff) do { _Pragma("unroll") for (int _i = 0; _i < 2; ++_i) \
        __builtin_amdgcn_global_load_lds((const unsigned*)((const char*)(gbase) + (voff)[_i]), (LAS unsigned*)(lds + (bufoff) + ldsw + _i * 8192), 16, 0, 0); } while (0)
#define PG8_LDA(dst, b, h) do { _Pragma("unroll") for (int m = 0; m < 4; ++m) _Pragma("unroll") for (int k = 0; k < 2; ++k) dst[m][k] = *(const LAS bf16x8*)(lds + PG8_SA(b, h) + aoff + m * 2048 + k * 1024); } while (0)
#define PG8_LDB(dst, b, h) do { _Pragma("unroll") for (int n = 0; n < 2; ++n) _Pragma("unroll") for (int k = 0; k < 2; ++k) dst[n][k] = *(const LAS bf16x8*)(lds + PG8_SB(b, h) + boff + n * 2048 + k * 1024); } while (0)
#define PG8_MMA(ai, bj, At, Bt) do { __builtin_amdgcn_s_setprio(1); _Pragma("unroll") for (int m = 0; m < 4; ++m) _Pragma("unroll") for (int n = 0; n < 2; ++n) _Pragma("unroll") for (int k = 0; k < 2; ++k) \
        acc[ai][bj][m][n] = __builtin_amdgcn_mfma_f32_16x16x32_bf16(Bt[n][k], At[m][k], acc[ai][bj][m][n], 0, 0, 0); __builtin_amdgcn_s_setprio(0); } while (0)
#define PG8_WAIT_V(n) asm volatile("s_waitcnt vmcnt(" #n ")" ::: "memory")
#define PG8_WAIT_L(n) asm volatile("s_waitcnt lgkmcnt(" #n ")" ::: "memory")
#define PG8_BAR __builtin_amdgcn_s_barrier()
#define PG8_SCHED __builtin_amdgcn_sched_barrier(0)
    Unit cur, nxt; int ui = 0;
    if (!S.next(0, cur)) return;
    f32x4 acc[2][2][4][2];
#pragma unroll
    for (int a = 0; a < 2; ++a)
#pragma unroll
        for (int b = 0; b < 2; ++b)
#pragma unroll
            for (int m = 0; m < 4; ++m)
#pragma unroll
                for (int n = 0; n < 2; ++n) acc[a][b][m][n] = (f32x4){0.f, 0.f, 0.f, 0.f};
    bf16x8 At[4][2], B0[2][2], B1[2][2];
    const char* cA = (const char*)g.A + (size_t)cur.pm * tstep; const char* cB = (const char*)g.Bt + (size_t)cur.pn * tstep;
    if constexpr (SP2) {
        PG8_STAGE(PG8_SB(0, 0), cB, voffB); PG8_STAGE(PG8_SB(0, 1), cB + hstep, voffB); PG8_STAGE(PG8_SA(0, 0), cA, voffA); PG8_STAGE(PG8_SA(0, 1), cA + hstep, voffA);
        if (wr == 1) PG8_BAR;
        PG8_WAIT_V(2); PG8_BAR;
        PG8_STAGE(PG8_SB(1, 0), cB + kstep, voffB); PG8_STAGE(PG8_SA(1, 0), cA + kstep, voffA); PG8_STAGE(PG8_SB(1, 1), cB + hstep + kstep, voffB);
        PG8_WAIT_V(6); PG8_BAR;
    } else {
        PG8_STAGE(PG8_SB(0, 0), cB, voffB); PG8_STAGE(PG8_SA(0, 0), cA, voffA); PG8_STAGE(PG8_SB(0, 1), cB + hstep, voffB); PG8_STAGE(PG8_SA(0, 1), cA + hstep, voffA);
        if (wr == 1) PG8_BAR;
        PG8_WAIT_V(4); PG8_BAR;
        PG8_STAGE(PG8_SB(1, 0), cB + kstep, voffB); PG8_STAGE(PG8_SA(1, 0), cA + kstep, voffA); PG8_STAGE(PG8_SB(1, 1), cB + hstep + kstep, voffB);
        PG8_WAIT_V(6); PG8_BAR;
    }
    for (;;) {
        const bool has_next = S.next(ui + 1, nxt);
        const char* nA = has_next ? (const char*)g.A + (size_t)nxt.pm * tstep : cA; const char* nB = has_next ? (const char*)g.Bt + (size_t)nxt.pn * tstep : cB;
        for (int t = 0; t < nt; t += 2) {
            const bool last = (t == nt - 2);
            const char* a1 = cA + (size_t)(t + 1) * kstep;
            const char* a2 = last ? nA : cA + (size_t)(t + 2) * kstep; const char* b2 = last ? nB : cB + (size_t)(t + 2) * kstep;
            const char* a3 = a2 + kstep; const char* b3 = b2 + kstep;
            if constexpr (SP2) {
            PG8_LDB(B0, 0, 0); PG8_LDB(B1, 0, 1); PG8_SCHED; PG8_LDA(At, 0, 0); PG8_STAGE(PG8_SA(1, 1), a1 + hstep, voffA);
            PG8_WAIT_V(8); PG8_WAIT_L(0); PG8_BAR; PG8_MMA(0, 0, At, B0); PG8_MMA(0, 1, At, B1); PG8_BAR; PG8_SCHED;
            PG8_LDA(At, 0, 1); PG8_STAGE(PG8_SB(0, 0), b2, voffB); PG8_STAGE(PG8_SB(0, 1), b2 + hstep, voffB); PG8_STAGE(PG8_SA(0, 0), a2, voffA);
            PG8_WAIT_V(8); PG8_WAIT_L(0); PG8_BAR; PG8_MMA(1, 0, At, B0); PG8_MMA(1, 1, At, B1); PG8_BAR; PG8_SCHED;
            PG8_LDB(B0, 1, 0); PG8_LDB(B1, 1, 1); PG8_SCHED; PG8_LDA(At, 1, 0); PG8_STAGE(PG8_SA(0, 1), a2 + hstep, voffA);
            PG8_WAIT_V(8); PG8_WAIT_L(0); PG8_BAR; PG8_MMA(0, 0, At, B0); PG8_MMA(0, 1, At, B1); PG8_BAR; PG8_SCHED;
            PG8_LDA(At, 1, 1); PG8_STAGE(PG8_SB(1, 0), b3, voffB); PG8_STAGE(PG8_SB(1, 1), b3 + hstep, voffB); PG8_STAGE(PG8_SA(1, 0), a3, voffA);
            PG8_WAIT_V(8); PG8_WAIT_L(0); PG8_BAR; PG8_MMA(1, 0, At, B0); PG8_MMA(1, 1, At, B1); PG8_BAR; PG8_SCHED;
            } else {
            PG8_LDB(B0, 0, 0); PG8_SCHED; PG8_LDA(At, 0, 0); PG8_STAGE(PG8_SA(1, 1), a1 + hstep, voffA);
            PG8_WAIT_L(8); PG8_BAR; PG8_WAIT_L(0); PG8_MMA(0, 0, At, B0); PG8_BAR; PG8_SCHED;
            PG8_LDB(B1, 0, 1); PG8_STAGE(PG8_SB(0, 0), b2, voffB);
            PG8_BAR; PG8_WAIT_L(0); PG8_MMA(0, 1, At, B1); PG8_BAR;
            PG8_LDA(At, 0, 1); PG8_STAGE(PG8_SA(0, 0), a2, voffA);
            PG8_BAR; PG8_WAIT_L(0); PG8_MMA(1, 0, At, B0); PG8_BAR; PG8_SCHED;
            PG8_STAGE(PG8_SB(0, 1), b2 + hstep, voffB);
            PG8_WAIT_V(6); PG8_BAR; PG8_MMA(1, 1, At, B1); PG8_BAR;
            PG8_LDB(B0, 1, 0); PG8_SCHED; PG8_LDA(At, 1, 0); PG8_STAGE(PG8_SA(0, 1), a2 + hstep, voffA);
            PG8_WAIT_L(8); PG8_BAR; PG8_WAIT_L(0); PG8_MMA(0, 0, At, B0); PG8_BAR; PG8_SCHED;
            PG8_LDB(B1, 1, 1); PG8_STAGE(PG8_SB(1, 0), b3, voffB);
            PG8_BAR; PG8_WAIT_L(0); PG8_MMA(0, 1, At, B1); PG8_BAR;
            PG8_LDA(At, 1, 1); PG8_STAGE(PG8_SA(1, 0), a3, voffA);
            PG8_BAR; PG8_WAIT_L(0); PG8_MMA(1, 0, At, B0); PG8_BAR; PG8_SCHED;
            PG8_STAGE(PG8_SB(1, 1), b3 + hstep, voffB);
            PG8_WAIT_V(6); PG8_BAR; PG8_MMA(1, 1, At, B1); PG8_BAR;
            }
        }
        if constexpr (ALIGN_EPI) { if (wr == 0) PG8_BAR; }
        E(acc, cur, wr, wc, fr, fq);
        if (!has_next) break;
#pragma unroll
        for (int a = 0; a < 2; ++a)
#pragma unroll
            for (int b = 0; b < 2; ++b)
#pragma unroll
                for (int m = 0; m < 4; ++m)
#pragma unroll
                    for (int n = 0; n < 2; ++n) acc[a][b][m][n] = (f32x4){0.f, 0.f, 0.f, 0.f};
        cur = nxt; cA = nA; cB = nB; ++ui;
        if constexpr (ALIGN_EPI) { if (wr == 1) PG8_BAR; }
    }
    PG8_WAIT_V(0);
    if constexpr (!ALIGN_EPI) { if (wr == 0) PG8_BAR; }
    PG8_BAR;
#undef PG8_SA
#undef PG8_SB
#undef PG8_STAGE
#undef PG8_LDA
#undef PG8_LDB
#undef PG8_MMA
#undef PG8_WAIT_V
#undef PG8_WAIT_L
#undef PG8_BAR
#undef PG8_SCHED
}
}

constexpr size_t MiB = 1u << 20;
constexpr size_t SZ_WIN = (size_t)2 * FF * DM * 2;
constexpr size_t SZ_WOUT = (size_t)DM * FF * 2;
constexpr size_t WS_WIN = 1 * MiB;
constexpr size_t WS_WOUT = WS_WIN + 4 * SZ_WIN;
constexpr size_t WS_WA = WS_WOUT + 4 * SZ_WOUT;
constexpr size_t WS_WOA = WS_WA + (size_t)18432 * DM * 2;
constexpr size_t WS_WKV = WS_WOA + (size_t)DM * DM * 2;
constexpr size_t WS_WQ = WS_WKV + (size_t)4096 * DM * 2;
constexpr size_t WS_WOB = WS_WQ + (size_t)DM * DM * 2;
constexpr size_t WS_XN = WS_WOB + (size_t)DM * DM * 2;
constexpr size_t SZ_XN = (size_t)MTOK * DM * 2;
constexpr size_t WS_BIG = WS_XN + 3 * SZ_XN;
constexpr size_t SZ_QK = (size_t)MTOK * 4096 * 2;
constexpr size_t WS_VT = WS_BIG + 3 * SZ_QK;
constexpr size_t WS_AO = WS_VT + 3 * SZ_XN;
constexpr size_t WS_LSE = WS_AO + SZ_XN;
constexpr size_t WS_OG0 = WS_LSE + 3 * MiB;
constexpr size_t WS_SSP = WS_OG0 + SZ_XN;
constexpr size_t WS_END = WS_SSP + 7 * 2 * MiB;
constexpr size_t WS_O1 = WS_BIG + 192 * MiB;

__device__ __forceinline__ void tr_item64(const float* __restrict__ W, int ldw, int K, bf16_t* WT, int src_col0, int dst_row0, int k0, LAS float* scr, int lane, const float* gain) {
    const int cq = lane & 15, rr = lane >> 4;
    f32x4 v[16];
#pragma unroll
    for (int i = 0; i < 16; ++i) v[i] = *(const f32x4*)(W + (size_t)(k0 + 4 * i + rr) * ldw + src_col0 + 4 * cq);
#pragma unroll
    for (int i = 0; i < 16; ++i) { LAS float* s = scr + (4 * i + rr) * 65 + 4 * cq; const float gk = gain ? gain[k0 + 4 * i + rr] : 1.f; s[0] = v[i].x * gk; s[1] = v[i].y * gk; s[2] = v[i].z * gk; s[3] = v[i].w * gk; }
    LDS_WAIT(); asm volatile("" ::: "memory");
    const int c = lane & 7;
#pragma unroll
    for (int j = 0; j < 8; ++j) { const int n = (lane >> 3) + 8 * j; const LAS float* s = scr + (8 * c) * 65 + n;
        u32x4 o; o.x = pk2(s[0 * 65], s[1 * 65]); o.y = pk2(s[2 * 65], s[3 * 65]); o.z = pk2(s[4 * 65], s[5 * 65]); o.w = pk2(s[6 * 65], s[7 * 65]);
        *(u32x4*)(WT + (size_t)(dst_row0 + n) * K + k0 + 8 * c) = o; }
    LDS_WAIT(); asm volatile("" ::: "memory");
}
__device__ __forceinline__ void conv_matrix(const float* W, int K, int N, bf16_t* WT, int kind, LAS float* scr, int gw, int NGW, int lane, const float* gain) {
    const int nnb = N / 64, items = (K / 64) * nnb;
    for (int it = gw; it < items; it += NGW) {
        const int kb = it / nnb, nb = it - kb * nnb, n0 = nb * 64;
        int d0 = n0;
        if (kind == 1) { const int half = n0 >= FF ? 1 : 0, j = n0 - half * FF; d0 = (j >> 7) * 256 + half * 128 + (j & 127); }
        else if (kind == 2) { const int sg = n0 >> 11, s = sg / 3, g = sg - 3 * s; d0 = g * 6144 + s * 2048 + (n0 & 2047); }
        tr_item64(W, N, K, WT, n0, d0, kb * 64, scr, lane, gain);
    }
}

__device__ __forceinline__ void prep_op(const float* in, bf16_t* xb, float* ss, int gw, int NGW, int lane) {
    for (int row = gw; row < MTOK; row += NGW) {
        const f32x4* xr = (const f32x4*)(in + (size_t)row * DM) + lane;
        f32x4 v[8]; float s = 0.f;
#pragma unroll
        for (int j = 0; j < 8; ++j) { v[j] = xr[64 * j]; s += (v[j].x * v[j].x + v[j].y * v[j].y) + (v[j].z * v[j].z + v[j].w * v[j].w); }
        s = wave_sum(s);
        if (lane < 32) ss[(size_t)row * 32 + lane] = (lane == 0) ? s : 0.f;
#pragma unroll
        for (int j = 0; j < 8; ++j) { u32x2 w; w.x = pk2(v[j].x, v[j].y); w.y = pk2(v[j].z, v[j].w); ((u32x2*)(xb + (size_t)row * DM))[64 * j + lane] = w; }
    }
}
__device__ __forceinline__ void final_norm_op(const bf16_t* xb, float* out, const float* g0, const float* ss, int gw, int NGW, int lane) {
    for (int row = gw; row < MTOK; row += NGW) {
        const u32x2* xr = (const u32x2*)(xb + (size_t)row * DM) + lane;
        f32x4* orow = (f32x4*)(out + (size_t)row * DM) + lane;
        const float rstd = rsqrtf(wave_sum(lane < 32 ? ss[(size_t)row * 32 + lane] : 0.f) * (1.f / DM) + 1e-6f);
#pragma unroll
        for (int j = 0; j < 8; ++j) { const u32x2 w = xr[64 * j]; const f32x4 g = ((const f32x4*)g0)[64 * j + lane];
            orow[64 * j] = (f32x4){bflo(w.x), bfhi(w.x), bflo(w.y), bfhi(w.y)} * rstd * g; }
    }
}

#define MFMA32(a, b, c) __builtin_amdgcn_mfma_f32_32x32x16_bf16((a), (b), (c), 0, 0, 0)
__device__ __forceinline__ int crow(int reg, int h) { return (reg & 3) + 8 * (reg >> 2) + 4 * h; }
__device__ __forceinline__ bf16x8 pack8(const f32x16& p, int s) {
    u32x4 w; w.x = pk2(p[8 * s], p[8 * s + 1]); w.y = pk2(p[8 * s + 2], p[8 * s + 3]); w.z = pk2(p[8 * s + 4], p[8 * s + 5]); w.w = pk2(p[8 * s + 6], p[8 * s + 7]);
    return __builtin_bit_cast(bf16x8, w);
}
__device__ __forceinline__ bf16x8 ldv(const bf16_t* p) {
    const u32x2 lo = *(const u32x2*)p, hi = *(const u32x2*)(p + 8);
    u32x4 w; w.x = lo.x; w.y = lo.y; w.z = hi.x; w.w = hi.y; return __builtin_bit_cast(bf16x8, w);
}

__device__ __forceinline__ float swap32_max(float v) { auto rr = __builtin_amdgcn_permlane32_swap(__float_as_uint(v), __float_as_uint(v), false, false); return fmaxf(__uint_as_float(rr[0]), __uint_as_float(rr[1])); }
__device__ __forceinline__ float swap32_sum(float v) { auto rr = __builtin_amdgcn_permlane32_swap(__float_as_uint(v), __float_as_uint(v), false, false); return __uint_as_float(rr[0]) + __uint_as_float(rr[1]); }
template <int NDT, int MODE>
__device__ __forceinline__ void attn_subtile(const LAS unsigned char* Kp, unsigned kfb, const LAS unsigned char* Vp, unsigned vfbs, const bf16x8 (&qf)[8], f32x16 (&O)[NDT],
                                             float& mrun, float& lrun, float sc2, float slope2, int dbase, bool edge) {
    f32x16 S;
#pragma unroll
    for (int i = 0; i < 16; ++i) S[i] = 0.f;
    {
        bf16x8 kf[8];
#pragma unroll
        for (int ks = 0; ks < 8; ++ks) kf[ks] = *(const LAS bf16x8*)(Kp + (kfb ^ (unsigned)(ks << 5)));
#pragma unroll
        for (int ks = 0; ks < 8; ++ks) S = MFMA32(kf[ks], qf[ks], S);
        __builtin_amdgcn_sched_group_barrier(0x100, 4, 0);
#pragma unroll
        for (int ks = 0; ks < 4; ++ks) { __builtin_amdgcn_sched_group_barrier(0x008, 1, 0); __builtin_amdgcn_sched_group_barrier(0x100, 1, 0); }
        __builtin_amdgcn_sched_group_barrier(0x008, 4, 0);
    }
    __builtin_amdgcn_sched_barrier(0);
    const float bb = -slope2 * (float)dbase - mrun;
#pragma unroll
    for (int i = 0; i < 16; ++i) { const int c = 16 * (i >> 3) + (i & 7); S[i] = fmaf(slope2, (float)c, fmaf(S[i], sc2, bb)); }
    if (edge) {
#pragma unroll
        for (int i = 0; i < 16; ++i) { const int dist = dbase - (16 * (i >> 3) + (i & 7));
            const bool ok = (MODE == 1) ? (dist >= 0) : (dist >= 0 && dist <= 128); S[i] = ok ? S[i] : -1e30f; }
    }
    float mx = fmaxf(fmaxf(S[0], S[1]), fmaxf(S[2], S[3]));
#pragma unroll
    for (int i = 4; i < 16; i += 4) mx = fmaxf(mx, fmaxf(fmaxf(S[i], S[i + 1]), fmaxf(S[i + 2], S[i + 3])));
    mx = swap32_max(mx);
    if (__builtin_amdgcn_ballot_w64(mx > 8.0f) != 0ull) {
        const float d = fmaxf(mx, 0.f), alpha = __builtin_amdgcn_exp2f(-d);
        lrun *= alpha; mrun += d;
#pragma unroll
        for (int dt = 0; dt < NDT; ++dt)
#pragma unroll
            for (int i = 0; i < 16; ++i) O[dt][i] *= alpha;
#pragma unroll
        for (int i = 0; i < 16; ++i) S[i] -= d;
    }
    float ps = 0.f;
#pragma unroll
    for (int i = 0; i < 16; ++i) { const float pv = __builtin_amdgcn_exp2f(S[i]); S[i] = pv; ps += pv; }
    lrun += swap32_sum(ps);
    const bf16x8 p0 = pack8(S, 0), p1 = pack8(S, 1);
    __builtin_amdgcn_sched_barrier(0);
    {
        bf16x8 v0[NDT], v1[NDT];
#pragma unroll
        for (int dt = 0; dt < NDT; ++dt) { v0[dt] = *(const LAS bf16x8*)(Vp + dt * 4096 + vfbs); v1[dt] = *(const LAS bf16x8*)(Vp + dt * 4096 + (vfbs ^ 32u)); }
#pragma unroll
        for (int dt = 0; dt < NDT; ++dt) { O[dt] = MFMA32(v0[dt], p0, O[dt]); O[dt] = MFMA32(v1[dt], p1, O[dt]); }
        __builtin_amdgcn_sched_group_barrier(0x100, 6, 0);
#pragma unroll
        for (int k = 0; k < 2 * NDT - 6; ++k) { __builtin_amdgcn_sched_group_barrier(0x008, 1, 0); __builtin_amdgcn_sched_group_barrier(0x100, 1, 0); }
        __builtin_amdgcn_sched_group_barrier(0x008, 6, 0);
    }
    __builtin_amdgcn_sched_barrier(0);
}

#define GLDS16(gp, lp) __builtin_amdgcn_global_load_lds((const unsigned*)(gp), (LAS unsigned*)(lp), 16, 0, 0)
__device__ __forceinline__ int pi32(int rho) { return (rho & 0x13) | ((rho & 4) << 1) | ((rho & 8) >> 1); }
__device__ __forceinline__ void attn_a_op(LAS unsigned char* lds, const bf16_t* QK, const bf16_t* VT, bf16_t* OG, bf16_t* AO, float* LSE, int G, int tid, int g0) {
    const int lane = tid & 63, wave = __builtin_amdgcn_readfirstlane(tid >> 6), r = lane & 31, h2 = lane >> 5;
    const float sc2 = 0.08838834764831845f * LOG2E;
    const int krow = pi32(r);
    const unsigned kfb = (unsigned)(krow * 256 + ((h2 ^ (krow & 15)) << 4));
    const unsigned vfb = (unsigned)(r * 128 + ((h2 ^ ((r >> 1) & 7)) << 4));
    for (int U = g0 * 1024 + (int)blockIdx.x; U < (g0 + 1) * 1024; U += G) {
        const int nb = U & 7, h = (U >> 3) & 15, b = (U >> 7) & 7, g = U >> 10;
        const int L = 2048 >> (2 * g);
        const int R0 = 256 * nb, qpos0 = R0 + 32 * wave, seq0 = qpos0 & ~(L - 1), lo = (qpos0 - 128 > seq0) ? qpos0 - 128 : seq0;
        const int t0 = ((R0 & ~(L - 1)) == R0) ? 2 : 0;
        const float slope2 = exp2f(-0.5f * (float)(h + 1)) * (float)(1 << (2 * g)) * LOG2E;
        const bf16_t* QKg = QK + (size_t)g * MTOK * 4096 + (size_t)(b * 2048) * 4096 + h * 128;
        const char* kg = (const char*)(QKg + 2048) + (ptrdiff_t)(R0 - 128) * (4096 * 2);
        const char* vg = (const char*)(VT + (size_t)g * DM * MTOK) + (ptrdiff_t)((b * 2048 + R0 - 128) >> 6) * 262144 + (size_t)(h * 128) * 128;
        bf16x8 qf[8];
        { const bf16_t* qp = QKg + (size_t)(qpos0 + r) * 4096 + 8 * h2;
#pragma unroll
          for (int ks = 0; ks < 8; ++ks) qf[ks] = *(const bf16x8*)(qp + 16 * ks); }
        f32x16 O[4];
#pragma unroll
        for (int dt = 0; dt < 4; ++dt)
#pragma unroll
            for (int i = 0; i < 16; ++i) O[dt][i] = 0.f;
        float mrun = -64.f, lrun = 0.f;
#define STAGE_A(t_, buf_) do { LAS unsigned char* kb_ = lds + (buf_) * 32768 + wave * 2048; const char* kgt_ = kg + (ptrdiff_t)(t_) * (64 * 4096 * 2); const char* vgt_ = vg + (ptrdiff_t)(t_) * 262144; \
            int ln_ = lane; asm volatile("" : "+v"(ln_)); \
            _Pragma("unroll") for (int i_ = 0; i_ < 2; ++i_) { const int j_ = wave * 2 + i_; \
                const int kr_ = 4 * j_ + (ln_ >> 4), kg_ = (ln_ & 15) ^ (kr_ & 15); GLDS16(kgt_ + (unsigned)(kr_ * 4096 * 2 + kg_ * 16), kb_ + i_ * 1024); \
                const int vr_ = 8 * j_ + (ln_ >> 3), vg_ = (ln_ & 7) ^ ((vr_ >> 1) & 7); GLDS16(vgt_ + ((unsigned)vr_ * 128u + (unsigned)(vg_ * 16)), kb_ + 16384 + i_ * 1024); } } while (0)
        STAGE_A(t0, t0 & 1);
        for (int t = t0; t < 6; ++t) {
            asm volatile("s_waitcnt vmcnt(0)\n\ts_barrier" ::: "memory");
            if (t + 1 < 6) STAGE_A(t + 1, (t + 1) & 1);
            const int kp0 = R0 - 128 + 64 * t;
            if (kp0 + 63 >= lo && kp0 <= qpos0 + 31) {
                const LAS unsigned char* Kb = lds + (t & 1) * 32768; const LAS unsigned char* Vb = Kb + 16384;
#pragma unroll 1
                for (int sub = 0; sub < 2; ++sub) {
                    const int kb0 = kp0 + 32 * sub;
                    if (kb0 + 31 >= lo && kb0 <= qpos0 + 31) {
                        const bool edge = (kb0 + 31 > qpos0) || (kb0 < qpos0 + 31 - 128);
                        attn_subtile<4, 2>(Kb + sub * 8192, kfb, Vb, vfb ^ (unsigned)(sub << 6), qf, O, mrun, lrun, sc2, slope2, qpos0 + r - kb0 - 8 * h2, edge);
                    }
                }
            }
        }
#undef STAGE_A
        const size_t grow = (size_t)(b * 2048 + qpos0 + r);
        if (g != 0) {
            const float inv = 1.f / lrun;
            bf16_t* op = OG + (size_t)g * MTOK * DM + grow * DM + h * 128 + 4 * h2;
#pragma unroll
            for (int dt = 0; dt < 4; ++dt)
#pragma unroll
                for (int q = 0; q < 4; ++q) { u32x2 w; w.x = pk2(O[dt][4 * q] * inv, O[dt][4 * q + 1] * inv); w.y = pk2(O[dt][4 * q + 2] * inv, O[dt][4 * q + 3] * inv);
                    *(u32x2*)(op + 32 * dt + 8 * q) = w; }
            if (h2 == 0) LSE[(size_t)g * MTOK * 16 + grow * 16 + h] = mrun + log2f(lrun);
        } else {
            const int t = qpos0 + r, bb = b * 2048;
            const size_t r1 = (size_t)(bb + (t & 3) * 512 + (t >> 2)), r2 = (size_t)(bb + (t & 15) * 128 + (t >> 4));
            const float e0 = mrun + log2f(lrun), e1 = LSE[(size_t)MTOK * 16 + r1 * 16 + h], e2 = LSE[(size_t)2 * MTOK * 16 + r2 * 16 + h];
            const float mxe = fmaxf(e0, fmaxf(e1, e2));
            float w0 = exp2f(e0 - mxe), w1 = exp2f(e1 - mxe), w2 = exp2f(e2 - mxe);
            const float winv = 1.f / (w0 + w1 + w2); w0 *= winv / lrun; w1 *= winv; w2 *= winv;
            __syncthreads();
            LAS unsigned char* mybuf = lds + wave * 17408;
#pragma unroll
            for (int j = 0; j < 8; ++j) { const int rr = 4 * j + (lane >> 4), c16 = lane & 15, tt = qpos0 + rr;
                const size_t q1 = (size_t)(bb + (tt & 3) * 512 + (tt >> 2)), q2 = (size_t)(bb + (tt & 15) * 128 + (tt >> 4));
                const u32x4 x1 = *(const u32x4*)(OG + (size_t)MTOK * DM + q1 * DM + h * 128 + c16 * 8);
                const u32x4 x2 = *(const u32x4*)(OG + (size_t)2 * MTOK * DM + q2 * DM + h * 128 + c16 * 8);
                *(LAS u32x4*)(mybuf + rr * 272 + c16 * 16) = x1; *(LAS u32x4*)(mybuf + 8704 + rr * 272 + c16 * 16) = x2; }
            LDS_WAIT(); asm volatile("" ::: "memory");
            const LAS unsigned char* l1 = mybuf + r * 272 + 8 * h2; const LAS unsigned char* l2 = l1 + 8704;
            bf16_t* op = AO + grow * DM + h * 128 + 4 * h2;
#pragma unroll
            for (int dt = 0; dt < 4; ++dt) {
#pragma unroll
                for (int q = 0; q < 4; ++q) { const u32x2 a = *(const LAS u32x2*)(l1 + (32 * dt + 8 * q) * 2), c = *(const LAS u32x2*)(l2 + (32 * dt + 8 * q) * 2); u32x2 w;
                    w.x = pk2(O[dt][4 * q] * w0 + w1 * bflo(a.x) + w2 * bflo(c.x), O[dt][4 * q + 1] * w0 + w1 * bfhi(a.x) + w2 * bfhi(c.x));
                    w.y = pk2(O[dt][4 * q + 2] * w0 + w1 * bflo(a.y) + w2 * bflo(c.y), O[dt][4 * q + 3] * w0 + w1 * bfhi(a.y) + w2 * bfhi(c.y));
                    *(u32x2*)(op + 32 * dt + 8 * q) = w; }
            }
        }
        __syncthreads();
    }
}
__device__ __forceinline__ void merge_op(const bf16_t* OG, const bf16_t* OG0, const float* LSE, bf16_t* AO, int gw, int NGW, int lane) {
    for (int rowp = 2 * gw; rowp < MTOK; rowp += 2 * NGW) {
        u32x4 a[2][4], bq[2][4], cq[2][4]; float w0[2], w1[2], w2[2];
#pragma unroll
        for (int k = 0; k < 2; ++k) {
            const int row = rowp + k, b = row >> 11, t = row & 2047, hd = lane >> 2;
            const int r0 = row, r1 = (b << 11) + (t & 3) * 512 + (t >> 2), r2 = (b << 11) + (t & 15) * 128 + (t >> 4);
            const u32x4* p0 = (const u32x4*)(OG0 + (size_t)r0 * DM + 32 * lane);
            const u32x4* p1 = (const u32x4*)(OG + (size_t)MTOK * DM + (size_t)r1 * DM + 32 * lane);
            const u32x4* p2 = (const u32x4*)(OG + (size_t)2 * MTOK * DM + (size_t)r2 * DM + 32 * lane);
#pragma unroll
            for (int c = 0; c < 4; ++c) { a[k][c] = p0[c]; bq[k][c] = p1[c]; cq[k][c] = p2[c]; }
            const float e0 = LSE[(size_t)r0 * 16 + hd], e1 = LSE[(size_t)MTOK * 16 + (size_t)r1 * 16 + hd], e2 = LSE[(size_t)2 * MTOK * 16 + (size_t)r2 * 16 + hd];
            const float mx = fmaxf(e0, fmaxf(e1, e2));
            float x0 = exp2f(e0 - mx), x1 = exp2f(e1 - mx), x2 = exp2f(e2 - mx);
            const float inv = 1.f / (x0 + x1 + x2); w0[k] = x0 * inv; w1[k] = x1 * inv; w2[k] = x2 * inv;
        }
#pragma unroll
        for (int k = 0; k < 2; ++k) {
            u32x4* po = (u32x4*)(AO + (size_t)(rowp + k) * DM + 32 * lane);
#pragma unroll
            for (int c = 0; c < 4; ++c) { u32x4 o;
#pragma unroll
                for (int j = 0; j < 4; ++j) { const float lo = w0[k] * bflo(a[k][c][j]) + w1[k] * bflo(bq[k][c][j]) + w2[k] * bflo(cq[k][c][j]), hi = w0[k] * bfhi(a[k][c][j]) + w1[k] * bfhi(bq[k][c][j]) + w2[k] * bfhi(cq[k][c][j]); o[j] = pk2(lo, hi); }
                po[c] = o; }
        }
    }
}
__device__ __forceinline__ void attn_b_op(LAS unsigned char* lds, const bf16_t* Q12, const bf16_t* K12, const bf16_t* VTb, const float* lam, const float* subg, bf16_t* AO, int G, int tid) {
    const int lane = tid & 63, wave = __builtin_amdgcn_readfirstlane(tid >> 6), r = lane & 31, h2 = lane >> 5, wq = wave & 3, m = wave >> 2;
    const float sc2 = 0.08838834764831845f * LOG2E;
    const float lambda_init = 0.8f - 0.6f * 0.7408182206817179f;
    float lam_full;
    { const float a = lam[lane] * lam[128 + lane] + lam[64 + lane] * lam[192 + lane], c = lam[256 + lane] * lam[384 + lane] + lam[320 + lane] * lam[448 + lane];
      lam_full = __int_as_float(__builtin_amdgcn_readfirstlane(__float_as_int(__expf(wave_sum(a)) - __expf(wave_sum(c)) + lambda_init))); }
    const int krow = pi32(r);
    const unsigned kfb = (unsigned)(krow * 512 + ((((16 * m + h2) ^ (krow & 15))) << 4));
    const unsigned vfb = (unsigned)(r * 128 + ((h2 ^ ((r >> 1) & 7)) << 4));
    for (int P = blockIdx.x; P < 512; P += G) {
        const int bh = P >> 3, pp = P & 7, b = bh >> 3, h = bh & 7;
        const float slope2 = exp2f(-(float)(h + 1)) * LOG2E;
        const char* kg = (const char*)(K12 + (size_t)(b * 2048) * DM + h * 256);
        const char* vg = (const char*)VTb + (size_t)(b * 32) * 262144 + (size_t)(h * 256) * 128;
        for (int which = 0; which < 2; ++which) {
            const int qb = which ? 15 - pp : pp;
            const int qpos0 = 128 * qb + 32 * wq, nkt = 2 * qb + 2;
            bf16x8 qf[8];
            { const bf16_t* qp = Q12 + (size_t)(b * 2048 + qpos0 + r) * DM + h * 256 + m * 128 + 8 * h2;
#pragma unroll
              for (int ks = 0; ks < 8; ++ks) qf[ks] = *(const bf16x8*)(qp + 16 * ks); }
            f32x16 O[8];
#pragma unroll
            for (int dt = 0; dt < 8; ++dt)
#pragma unroll
                for (int i = 0; i < 16; ++i) O[dt][i] = 0.f;
            float mrun = -64.f, lrun = 0.f;
#define STAGE_B(kt_, buf_) do { LAS unsigned char* kb_ = lds + (buf_) * 65536 + wave * 4096; const char* kgt_ = kg + (size_t)(kt_) * (64 * DM * 2); const char* vgt_ = vg + (size_t)(kt_) * 262144; \
            int ln_ = lane; asm volatile("" : "+v"(ln_)); \
            _Pragma("unroll") for (int i_ = 0; i_ < 4; ++i_) { const int j_ = wave * 4 + i_; \
                const int kr_ = 2 * j_ + (ln_ >> 5), kg_ = (ln_ & 31) ^ (kr_ & 15); GLDS16(kgt_ + (unsigned)(kr_ * DM * 2 + kg_ * 16), kb_ + i_ * 1024); \
                const int vr_ = 8 * j_ + (ln_ >> 3), vg_ = (ln_ & 7) ^ ((vr_ >> 1) & 7); GLDS16(vgt_ + ((unsigned)vr_ * 128u + (unsigned)(vg_ * 16)), kb_ + 32768 + i_ * 1024); } } while (0)
            STAGE_B(0, 0);
            for (int kt = 0; kt < nkt; ++kt) {
                asm volatile("s_waitcnt vmcnt(0)\n\ts_barrier" ::: "memory");
                if (kt + 1 < nkt) STAGE_B(kt + 1, (kt + 1) & 1);
                if (64 * kt <= qpos0 + 31) {
                    const LAS unsigned char* Kb = lds + (kt & 1) * 65536; const LAS unsigned char* Vb = Kb + 32768;
                    const bool diag = (64 * kt + 63 > qpos0);
#pragma unroll 1
                    for (int sub = 0; sub < 2; ++sub) {
                        const int kb0 = 64 * kt + 32 * sub;
                        if (kb0 <= qpos0 + 31) {
                            attn_subtile<8, 1>(Kb + sub * 16384, kfb, Vb, vfb ^ (unsigned)(sub << 6), qf, O, mrun, lrun, sc2, slope2, qpos0 + r - kb0 - 8 * h2, diag);
                        }
                    }
                }
            }
#undef STAGE_B
            const float scl = (m == 0) ? (1.f / lrun) : (lam_full / lrun);
            __syncthreads();
            LAS float* xme = (LAS float*)(lds + wave * 16384) + lane;
            const LAS float* xpa = (const LAS float*)(lds + (wave ^ 4) * 16384) + lane;
            LAS float* ssx = (LAS float*)(lds + 131072);
            if (m == 0) {
#pragma unroll
                for (int dtl = 0; dtl < 4; ++dtl)
#pragma unroll
                    for (int i = 0; i < 16; ++i) xme[(dtl * 16 + i) * 64] = O[4 + dtl][i] * scl;
            } else {
#pragma unroll
                for (int dtl = 0; dtl < 4; ++dtl)
#pragma unroll
                    for (int i = 0; i < 16; ++i) xme[(dtl * 16 + i) * 64] = O[dtl][i] * scl;
            }
            __syncthreads();
            float ss = 0.f;
            if (m == 0) {
#pragma unroll
                for (int dtl = 0; dtl < 4; ++dtl)
#pragma unroll
                    for (int i = 0; i < 16; ++i) { const float o = O[dtl][i] * scl - xpa[(dtl * 16 + i) * 64]; O[dtl][i] = o; ss += o * o; }
            } else {
#pragma unroll
                for (int dtl = 0; dtl < 4; ++dtl)
#pragma unroll
                    for (int i = 0; i < 16; ++i) { const float o = xpa[(dtl * 16 + i) * 64] - O[4 + dtl][i] * scl; O[dtl][i] = o; ss += o * o; }
            }
            ss += __shfl_xor(ss, 32);
            if (h2 == 0) ssx[wave * 32 + r] = ss;
            __syncthreads();
            ss += ssx[(wave ^ 4) * 32 + r];
            const float rn = rsqrtf(ss * (1.f / 256.f) + 1e-5f) * (1.f - lambda_init);
            bf16_t* op = AO + (size_t)(b * 2048 + qpos0 + r) * DM + h * 256 + m * 128 + 4 * h2;
            const float* gp = subg + m * 128 + 4 * h2;
#pragma unroll
            for (int dtl = 0; dtl < 4; ++dtl)
#pragma unroll
                for (int q = 0; q < 4; ++q) { const f32x4 gg = *(const f32x4*)(gp + 32 * dtl + 8 * q);
                    u32x2 w; w.x = pk2(O[dtl][4 * q] * rn * gg.x, O[dtl][4 * q + 1] * rn * gg.y); w.y = pk2(O[dtl][4 * q + 2] * rn * gg.z, O[dtl][4 * q + 3] * rn * gg.w);
                    *(u32x2*)(op + 32 * dtl + 8 * q) = w; }
            __syncthreads();
        }
    }
}


#define XB_TMO      128
#define XB_XCNT(j)  (256  + 64 * (j))
#define XB_XSUB(j)  (1280 + 64 * (j))
#define XB_XGEN(j)  (2304 + 64 * (j))
#define XB_TOP      3328
#define XB_TOPGEN   3392
#define XCD_BAR_WORDS 3456
#define XB_SPIN_CAP (1u << 22)
__device__ __forceinline__ unsigned xb_ld(unsigned* p)              { return __hip_atomic_load(p, __ATOMIC_RELAXED, __HIP_MEMORY_SCOPE_AGENT); }
__device__ __forceinline__ unsigned xb_add(unsigned* p, unsigned v) { return __hip_atomic_fetch_add(p, v, __ATOMIC_RELAXED, __HIP_MEMORY_SCOPE_AGENT); }
__device__ __forceinline__ unsigned xb_xcc_id() { return (unsigned)__builtin_amdgcn_s_getreg((3 << 11) | 20) & 0xFu; }
#define XB_SPIN(cond, bar) do { unsigned _sp = 0; while (cond) { __builtin_amdgcn_s_sleep(1); \
    if ((++_sp & 255u) == 0u) { if (xb_ld(&(bar)[XB_TMO])) break; if (_sp > XB_SPIN_CAP) { atomicAdd(&(bar)[XB_TMO], 1u); break; } } } } while (0)
__device__ __forceinline__ void xcd_barrier_complete(unsigned* bar, unsigned x, unsigned& nloc, unsigned& nx) {
    const unsigned G = gridDim.x * gridDim.y * gridDim.z;
    unsigned sum, cnt, mine, sp = 0u;
    for (;;) {
        sum = 0u; cnt = 0u; mine = 0u;
#pragma unroll
        for (unsigned j = 0; j < 16; ++j) { const unsigned c = xb_ld(&bar[XB_XCNT(j)]); sum += c; cnt += (c > 0u) ? 1u : 0u; mine = (j == x) ? c : mine; }
        if (sum == G) break;
        __builtin_amdgcn_s_sleep(1);
        if ((++sp & 255u) == 0u) { if (xb_ld(&bar[XB_TMO])) break; if (sp > XB_SPIN_CAP) { atomicAdd(&bar[XB_TMO], 1u); break; } }
    }
    nloc = mine > 0u ? mine : 1u; nx = cnt > 0u ? cnt : 1u;
}
__device__ __forceinline__ void xcd_barrier(unsigned* bar, volatile LAS unsigned* st) {
    asm volatile("s_waitcnt vmcnt(0)" ::: "memory");
    __syncthreads();
    if (threadIdx.x == 0) {
        const unsigned x = xb_xcc_id();
        __builtin_amdgcn_s_waitcnt(0);
        unsigned nloc = st[0], nx = st[1];
        if (nloc == 0u) { xcd_barrier_complete(bar, x, nloc, nx); st[0] = nloc; st[1] = nx; }
        const unsigned old = xb_add(&bar[XB_XSUB(x)], 1u);
        const unsigned gen = old / nloc;
        if (old + 1u == (gen + 1u) * nloc) {
            __builtin_amdgcn_fence(__ATOMIC_RELEASE, "agent");
            asm volatile("s_waitcnt vmcnt(0)" ::: "memory");
            const unsigned og = xb_add(&bar[XB_TOP], 1u);
            const unsigned tg = og / nx;
            if (og + 1u == (tg + 1u) * nx) xb_add(&bar[XB_TOPGEN], 1u);
            else XB_SPIN(xb_ld(&bar[XB_TOPGEN]) == tg, bar);
            __builtin_amdgcn_fence(__ATOMIC_ACQUIRE, "agent");
            xb_add(&bar[XB_XGEN(x)], 1u);
            asm volatile("s_waitcnt vmcnt(0)" ::: "memory");
        } else {
            XB_SPIN(xb_ld(&bar[XB_XGEN(x)]) == gen, bar);
            __builtin_amdgcn_fence(__ATOMIC_ACQUIRE, "agent");
            asm volatile("s_waitcnt vmcnt(0)" ::: "memory");
        }
    }
    __syncthreads();
}

struct Args { const float* in[13]; float* out; unsigned char* ws; int lo, hi; };
constexpr int N_OPS = 26;
struct OpD { int kind, sync; unsigned long long a_off, b_off, o_off; int M, N, ld, i0, ss_in, ss_out, mode; float scale; };
#define WS_H WS_BIG
#define SS(k) ((int)(WS_SSP + (size_t)(k) * 2 * MiB))
__device__ const OpD OPS[N_OPS] = {
      {0, 0, 0, 0, 0, 0, 0, 0, 0, 0, 0, 0, 0.f},
      {1, 1, 0, 0, 0, 0, 0, 0, 0, 0, SS(0), 0, 0.f},
      {2, 1, WS_XN, WS_WIN + 0 * SZ_WIN, WS_H, MTOK, 2 * FF, FF, 0, SS(0), 0, 0, 0.f},
      {3, 1, WS_H, WS_WOUT + 0 * SZ_WOUT, WS_XN, MTOK, DM, DM, 0, (int)WS_XN, SS(1), 1, 0.5f},
      {4, 0, WS_XN + 1 * SZ_XN, WS_WA + (size_t)1 * 6144 * DM * 2, WS_BIG + 1 * SZ_QK, MTOK, 4096, 4096, 0, SS(1), 0, 1, 0.f},
      {4, 1, WS_WA + (size_t)(1 * 6144 + 4096) * DM * 2, WS_XN + 1 * SZ_XN, WS_VT + 1 * SZ_XN, DM, MTOK, MTOK, 0, SS(1), 0, 4, 0.f},
      {5, 0, 0, 0, 0, 0, 0, 0, 0, 0, 0, 1, 0.f},
      {4, 0, WS_XN + 2 * SZ_XN, WS_WA + (size_t)2 * 6144 * DM * 2, WS_BIG + 2 * SZ_QK, MTOK, 4096, 4096, 0, SS(1), 0, 2, 0.f},
      {4, 1, WS_WA + (size_t)(2 * 6144 + 4096) * DM * 2, WS_XN + 2 * SZ_XN, WS_VT + 2 * SZ_XN, DM, MTOK, MTOK, 0, SS(1), 0, 5, 0.f},
      {5, 0, 0, 0, 0, 0, 0, 0, 0, 0, 0, 2, 0.f},
      {4, 0, WS_XN + 0 * SZ_XN, WS_WA + (size_t)0 * 6144 * DM * 2, WS_BIG + 0 * SZ_QK, MTOK, 4096, 4096, 0, SS(1), 0, 0, 0.f},
      {4, 1, WS_WA + (size_t)(0 * 6144 + 4096) * DM * 2, WS_XN + 0 * SZ_XN, WS_VT + 0 * SZ_XN, DM, MTOK, MTOK, 0, SS(1), 0, 3, 0.f},
      {5, 1, 0, 0, 0, 0, 0, 0, 0, 0, 0, 0, 0.f},
      {9, 1, WS_AO, WS_WOA, WS_XN, MTOK, DM, DM, -1, (int)WS_XN, SS(2), 0, 1.0f},
      {2, 1, WS_XN, WS_WIN + 1 * SZ_WIN, WS_H, MTOK, 2 * FF, FF, 0, SS(2), 0, 0, 0.f},
      {3, 1, WS_H, WS_WOUT + 1 * SZ_WOUT, WS_XN, MTOK, DM, DM, -1, (int)WS_XN, SS(3), 0, 0.5f},
      {2, 1, WS_XN, WS_WIN + 2 * SZ_WIN, WS_H, MTOK, 2 * FF, FF, 0, SS(3), 0, 0, 0.f},
      {3, 1, WS_H, WS_WOUT + 2 * SZ_WOUT, WS_XN + SZ_XN, MTOK, DM, DM, -1, (int)WS_XN, SS(4), 0, 0.5f},
      {4, 0, WS_XN + SZ_XN, WS_WQ, WS_VT + 2 * SZ_XN, MTOK, DM, DM, 0, SS(4), 0, 0, 0.f},
      {4, 0, WS_XN, WS_WKV, WS_VT + 0 * SZ_XN, MTOK, DM, DM, 0, SS(3), 0, 0, 0.f},
      {4, 1, WS_WKV + (size_t)DM * DM * 2, WS_XN, WS_VT + 1 * SZ_XN, DM, MTOK, MTOK, 0, SS(3), 0, 3, 0.f},
      {7, 1, 0, 0, 0, 0, 0, 0, 0, 0, 0, 0, 0.f},
      {9, 1, WS_AO, WS_WOB, WS_XN + SZ_XN, MTOK, DM, DM, -1, (int)(WS_XN + SZ_XN), SS(5), 0, 1.0f},
      {2, 1, WS_XN + SZ_XN, WS_WIN + 3 * SZ_WIN, WS_H, MTOK, 2 * FF, FF, 0, SS(5), 0, 0, 0.f},
      {3, 1, WS_H, WS_WOUT + 3 * SZ_WOUT, WS_XN + SZ_XN, MTOK, DM, DM, -1, (int)(WS_XN + SZ_XN), SS(6), 0, 0.5f},
      {8, 0, WS_XN + SZ_XN, 0, 0, 0, 0, 0, 0, SS(6), 0, 0, 0.f},
};

__global__ void __launch_bounds__(NTHREADS, 2) fwd(Args args) {
    extern __shared__ __attribute__((aligned(16))) unsigned char lds_raw[];
    LAS unsigned char* lds = (LAS unsigned char*)lds_raw;
    const int G = gridDim.x, NGW = G * NWAVES;
    volatile LAS unsigned* bst = (volatile LAS unsigned*)(lds + LDS_BYTES - 256);
    if (threadIdx.x < 2) bst[threadIdx.x] = 0u;
    if (threadIdx.x == 0) (void)xb_add((unsigned*)args.ws + XB_XCNT(xb_xcc_id()), 1u);
    __syncthreads();

    for (int op = args.lo; op < args.hi; ++op) {
        const OpD d = OPS[op];
        for (int rep = 0; rep < ((op == REP_OP) ? REP_N : 1); ++rep) {
        int tid = threadIdx.x; asm volatile("" : "+v"(tid));
        const int lane = tid & 63, wave = __builtin_amdgcn_readfirstlane(tid >> 6), gw = blockIdx.x * NWAVES + wave;
        unsigned char* ws = args.ws;
        float* X = args.out;
        if (d.kind == 0) {
            LAS float* scr = (LAS float*)(lds + wave * 16640);
            const float* w_in = args.in[2]; const float* gains = args.in[1];
            for (int f = 0; f < 4; ++f) conv_matrix(w_in + (size_t)f * DM * 2 * FF, DM, 2 * FF, (bf16_t*)(ws + WS_WIN) + (size_t)f * 2 * FF * DM, 1, scr, gw, NGW, lane, gains + ((f >> 1) * 3 + (f & 1) * 2) * DM);
            conv_matrix(args.in[4], DM, 18432, (bf16_t*)(ws + WS_WA), 2, scr, gw, NGW, lane, gains + 1 * DM);
            conv_matrix(args.in[5], DM, DM, (bf16_t*)(ws + WS_WOA), 0, scr, gw, NGW, lane, nullptr);
            conv_matrix(args.in[7], DM, 4096, (bf16_t*)(ws + WS_WKV), 0, scr, gw, NGW, lane, args.in[6]);
            conv_matrix(args.in[8], DM, DM, (bf16_t*)(ws + WS_WQ), 0, scr, gw, NGW, lane, gains + 4 * DM);
            conv_matrix(args.in[11], DM, DM, (bf16_t*)(ws + WS_WOB), 0, scr, gw, NGW, lane, nullptr);
            __syncthreads();
        } else if (d.kind == 1) {
            prep_op(args.in[0], (bf16_t*)(ws + WS_XN), (float*)(ws + d.ss_out), gw, NGW, lane);
        } else if (d.kind == 2) {
            pg8::Gemm gm{(const bf16_t*)(ws + d.a_off), (const bf16_t*)(ws + d.b_off), d.M, d.N, DM};
            pg8::StaticOrder S; S.init(gm.M, gm.N, G, (int)blockIdx.x);
            pg8::EpiSwiGLU E{(bf16_t*)(ws + d.o_off), FF, (const float*)(ws + d.ss_in)};
            pg8::gemm_phase<DM, pg8::EpiSwiGLU, pg8::StaticOrder, true, true>(lds, gm, S, E, tid);
            if (G == 256 ? (int)blockIdx.x >= 192 : true) {
                const int tw = (G == 256) ? ((int)blockIdx.x - 192) * NWAVES + wave : gw, TW = (G == 256) ? 64 * NWAVES : NGW;
                LAS float* scr = (LAS float*)(lds + wave * 16640);
                const float* w_out = args.in[3];
                const int f = (int)((d.b_off - WS_WIN) / SZ_WIN);
                conv_matrix(w_out + (size_t)f * FF * DM, FF, DM, (bf16_t*)(ws + WS_WOUT) + (size_t)f * DM * FF, 0, scr, tw, TW, lane, nullptr);
            }
        } else if (d.kind == 3) {
            pg8::Gemm gm{(const bf16_t*)(ws + d.a_off), (const bf16_t*)(ws + d.b_off), d.M, d.N, FF};
            pg8::StaticOrder S; S.init(gm.M, gm.N, G, (int)blockIdx.x, 4);
            pg8::EpiResid E{X, DM, d.scale, (bf16_t*)(ws + d.o_off), (float*)(ws + d.ss_out), d.mode & 1, d.mode >> 1, (const bf16_t*)(ws + (size_t)d.ss_in)};
            pg8::gemm_phase<FF, pg8::EpiResid, pg8::StaticOrder, true, true>(lds, gm, S, E, tid);
        } else if (d.kind == 9) {
            pg8::Gemm gm{(const bf16_t*)(ws + d.a_off), (const bf16_t*)(ws + d.b_off), d.M, d.N, DM};
            pg8::StaticOrder S; S.init(gm.M, gm.N, G, (int)blockIdx.x, 4);
            pg8::EpiResid E{X, DM, d.scale, (bf16_t*)(ws + d.o_off), (float*)(ws + d.ss_out), 0, 0, (const bf16_t*)(ws + (size_t)d.ss_in)};
            pg8::gemm_phase<DM, pg8::EpiResid, pg8::StaticOrder, true, true>(lds, gm, S, E, tid);
        } else if (d.kind == 4) {
            pg8::Gemm gm{(const bf16_t*)(ws + d.a_off), (const bf16_t*)(ws + d.b_off), d.M, d.N, DM};
            pg8::StaticOrder S; S.init(gm.M, gm.N, G, (int)blockIdx.x);
            pg8::EpiBf16 E{(bf16_t*)(ws + d.o_off), d.ld, (const float*)(ws + d.ss_in), d.mode};
            pg8::gemm_phase<DM, pg8::EpiBf16, pg8::StaticOrder, true, true>(lds, gm, S, E, tid);
        } else if (d.kind == 5) {
            attn_a_op(lds, (const bf16_t*)(ws + WS_BIG), (const bf16_t*)(ws + WS_VT), (bf16_t*)(ws + WS_XN), (bf16_t*)(ws + WS_AO), (float*)(ws + WS_LSE), G, tid, d.mode);
        } else if (d.kind == 6) {
            merge_op((const bf16_t*)(ws + WS_XN), (const bf16_t*)(ws + WS_OG0), (const float*)(ws + WS_LSE), (bf16_t*)(ws + WS_AO), gw, NGW, lane);
        } else if (d.kind == 7) {
            attn_b_op(lds, (const bf16_t*)(ws + WS_VT + 2 * SZ_XN), (const bf16_t*)(ws + WS_VT), (const bf16_t*)(ws + WS_VT + SZ_XN), args.in[9], args.in[10], (bf16_t*)(ws + WS_AO), G, tid);
        } else {
            final_norm_op((const bf16_t*)(ws + d.a_off), X, args.in[12], (const float*)(ws + d.ss_in), gw, NGW, lane);
        }
        if (d.sync && op + 1 < args.hi) { if (args.hi > 1000) cg::this_grid().sync(); else xcd_barrier((unsigned*)args.ws, bst); }
        if (SYNC_EXTRA > 0 && op == 1 && op + 1 < args.hi) for (int e = 0; e < SYNC_EXTRA; ++e) xcd_barrier((unsigned*)args.ws, bst);
        }
    }
}

extern "C" void kernel_launch(void* const* d_in, const int* in_sizes, int n_in, void* d_out, int out_size, void* d_ws, size_t ws_size, hipStream_t stream) {
    static int grid = 0;
    if (grid == 0) {
        if (n_in != 13 || out_size != MTOK * DM || ws_size < WS_END) { fprintf(stderr, "kernel_launch: unexpected shapes: n_in %d out %d ws %zu (need %zu)\n", n_in, out_size, ws_size, (size_t)WS_END); grid = -1; return; }
        int dev = 0, cus = 0, per_cu = 0;
        (void)hipGetDevice(&dev); (void)hipDeviceGetAttribute(&cus, hipDeviceAttributeMultiprocessorCount, dev);
        if (hipFuncSetAttribute((const void*)fwd, hipFuncAttributeMaxDynamicSharedMemorySize, LDS_BYTES) != hipSuccess) { fprintf(stderr, "kernel_launch: hipFuncSetAttribute failed\n"); grid = -1; return; }
        if (hipOccupancyMaxActiveBlocksPerMultiprocessor(&per_cu, (const void*)fwd, NTHREADS, LDS_BYTES) != hipSuccess || per_cu < 1) { fprintf(stderr, "kernel_launch: occupancy query says %d\n", per_cu); per_cu = 1; }
        (void)hipGetLastError();
        grid = cus * per_cu;
    }
    if (grid < 0) return;
    (void)hipMemsetAsync(d_ws, 0, 16384, stream);
    Args a{};
    for (int i = 0; i < 13; ++i) a.in[i] = (const float*)d_in[i];
    a.out = (float*)d_out; a.ws = (unsigned char*)d_ws;
#if ONE_LAUNCH
    a.lo = 0; a.hi = N_OPS;
    void* params[] = {&a};
    hipError_t e = hipLaunchCooperativeKernel((const void*)fwd, dim3(grid), dim3(NTHREADS), params, LDS_BYTES, stream);
    if (e != hipSuccess) fprintf(stderr, "cooperative launch failed: %s (grid %d)\n", hipGetErrorString(e), grid);
#else
    for (int op = 0; op < N_OPS; ++op) { a.lo = op; a.hi = op + 1; hipLaunchKernelGGL(fwd, dim3(grid), dim3(NTHREADS), LDS_BYTES, stream, a); }
#endif
}
```
